# Optimizing an MI355X kernel written in HIP

```python
import math
import jax, jax.numpy as jnp
from jax import lax
import numpy as np

D_MODEL = 1024
BATCH = 8
SEQ = 4096
DEPTH = 4

N_MIXERS = 3
EXPAND = 2
D_INNER = EXPAND * D_MODEL
LN_EPS = 1e-5
DEEPNORM_ALPHA = (2.0 * DEPTH) ** 0.25
DEEPNORM_BETA = (8.0 * DEPTH) ** -0.25

HY_SHORT_CONV = 3
HY_EMB_DIM = 33
HY_FILTER_HIDDEN = 64
HY_FAST_DECAY_PCT = 0.3
HY_SLOW_DECAY_PCT = 1.5
HY_DECAY_TARGET = 1e-2
HY_IN_DIM = 4 * D_INNER

SSD_HEADDIM = 64
SSD_HEADS = D_INNER // SSD_HEADDIM
SSD_STATE = 128
SSD_GROUPS = 4
SSD_CONV = 5
SSD_CHUNK = 128
SSD_CONV_DIM = D_INNER + 2 * SSD_GROUPS * SSD_STATE
SSD_IN_DIM = D_INNER + SSD_CONV_DIM + 2 * SSD_HEADS
SSD_DT_MIN = 1e-3
SSD_DT_MAX = 1e-1

HG_HEADS = 16
HG_KEY_DIM = 128
HG_VAL_DIM = D_INNER // HG_HEADS
HG_FDIM = HG_HEADS * HG_KEY_DIM
HG_CHUNK = 64
HG_IN_DIM = 3 * HG_FDIM + 2 * D_INNER

kernel_name = "hybrid_hyena_ssd_hgrn2_deepnorm_encoder"


def layer_norm(x, g, b):
    xf = x.astype(jnp.float32)
    mu = jnp.mean(xf, axis=-1, keepdims=True)
    var = jnp.mean(jnp.square(xf - mu), axis=-1, keepdims=True)
    return (xf - mu) * lax.rsqrt(var + LN_EPS) * g + b


def rms_norm_groups(x, g, n_groups):
    shp = x.shape
    xf = x.astype(jnp.float32).reshape(shp[:-1] + (n_groups, shp[-1] // n_groups))
    xf = xf * lax.rsqrt(jnp.mean(jnp.square(xf), axis=-1, keepdims=True) + LN_EPS)
    return xf.reshape(shp) * g


def centred_depthwise_conv(x, w, b):
    k = w.shape[0]
    pad = k // 2
    L = x.shape[1]
    xp = jnp.pad(x, ((0, 0), (pad, pad), (0, 0)))
    return sum(xp[:, j:j + L] * w[j] for j in range(k)) + b


def hyena_filters(L, w1, b1, w2, b2, w3, b3, freq, w_out):
    t = jnp.linspace(0.0, 1.0, L, dtype=jnp.float32)[:, None]
    bands = (HY_EMB_DIM - 1) // 2
    w = 2.0 * math.pi * jnp.arange(L, dtype=jnp.float32)[:, None] / L
    f = jnp.linspace(1e-4, bands - 1, bands, dtype=jnp.float32)[None, :]
    z = jnp.concatenate([t, jnp.cos(f * w), -jnp.sin(f * w)], axis=-1)
    fr = freq.astype(jnp.float32)
    h = jnp.sin(fr * (z @ w1.astype(jnp.float32) + b1))
    h = jnp.sin(fr * (h @ w2.astype(jnp.float32) + b2))
    h = jnp.sin(fr * (h @ w3.astype(jnp.float32) + b3))
    h = h @ w_out.astype(jnp.float32)
    min_d = math.log(HY_DECAY_TARGET) / HY_FAST_DECAY_PCT
    max_d = math.log(HY_DECAY_TARGET) / HY_SLOW_DECAY_PCT
    deltas = jnp.abs(jnp.linspace(min_d, max_d, D_INNER, dtype=jnp.float32))
    h = h * jnp.exp(-t * jnp.concatenate([deltas, deltas]))
    return h[:, :D_INNER], h[:, D_INNER:]


def bidirectional_fftconv(u, h_fwd, h_bwd, skip):
    L = u.shape[1]
    n = 2 * L
    kfull = jnp.concatenate([h_fwd, jnp.zeros((1, h_fwd.shape[1]), jnp.float32), h_bwd[:0:-1]], axis=0)
    k_f = jnp.fft.rfft(kfull, n=n, axis=0)
    uf32 = u.astype(jnp.float32)
    u_f = jnp.fft.rfft(uf32, n=n, axis=1)
    y = jnp.fft.irfft(u_f * k_f[None], n=n, axis=1)[:, :L]
    return y + uf32 * skip.astype(jnp.float32)


def hyena_mixer(x, w_in, conv_w, conv_b, filt_w1, filt_b1, filt_w2, filt_b2, filt_w3, filt_b3,
                filt_freq, filt_w_out, skip, w_out):
    L = x.shape[1]
    proj = x @ w_in
    u, z = proj[..., :3 * D_INNER], proj[..., 3 * D_INNER:]
    u = centred_depthwise_conv(u, conv_w, conv_b)
    x0, x1, v = jnp.split(u.astype(jnp.float32), 3, axis=-1)
    h_f, h_b = hyena_filters(L, filt_w1, filt_b1, filt_w2, filt_b2, filt_w3, filt_b3, filt_freq, filt_w_out)
    y = x0 * bidirectional_fftconv(x1 * v, h_f, h_b, skip)
    y = y * jax.nn.silu(z.astype(jnp.float32))
    return (y.astype(x.dtype) @ w_out).astype(x.dtype)


def segsum(a):
    T = a.shape[-1]
    cs = jnp.cumsum(a, axis=-1)
    diff = cs[..., :, None] - cs[..., None, :]
    return jnp.where(jnp.tril(jnp.ones((T, T), dtype=bool)), diff, -jnp.inf)


def ssd_chunked(xh, dt, a, bm, cm):
    b, L, h, p = xh.shape
    g, n = bm.shape[2], bm.shape[3]
    hg = h // g
    T = SSD_CHUNK
    nc = L // T
    xdt = (xh * dt[..., None]).reshape(b, nc, T, g, hg, p)
    adt = jnp.moveaxis((dt * a).reshape(b, nc, T, g, hg), 2, -1)
    a_cs = jnp.cumsum(adt, axis=-1)
    bc = bm.reshape(b, nc, T, g, n)
    cc = cm.reshape(b, nc, T, g, n)
    lmat = jnp.exp(segsum(adt))
    cb = jnp.einsum('bctgn,bcsgn->bcgts', cc, bc)
    y_diag = jnp.einsum('bcgts,bcghts,bcsghp->bctghp', cb, lmat, xdt)
    decay_states = jnp.exp(a_cs[..., -1:] - a_cs)
    states = jnp.einsum('bcsgn,bcghs,bcsghp->bcghpn', bc, decay_states, xdt)
    chunk_decay = jnp.pad(jnp.moveaxis(a_cs[..., -1], 1, -1), ((0, 0), (0, 0), (0, 0), (1, 0)))
    dchunk = jnp.exp(segsum(chunk_decay))
    states0 = jnp.concatenate([jnp.zeros_like(states[:, :1]), states], axis=1)
    new_states = jnp.einsum('bghzc,bcghpn->bzghpn', dchunk, states0)
    prev_states = new_states[:, :-1]
    y_off = jnp.einsum('bctgn,bcghpn,bcght->bctghp', cc, prev_states, jnp.exp(a_cs))
    return (y_diag + y_off).reshape(b, L, h, p)


def ssd_mixer(x, w_in, conv_w, conv_b, dt_bias, a_log, d_skip, norm_g, w_out):
    b, L, _ = x.shape
    gn = SSD_GROUPS * SSD_STATE
    proj = x @ w_in
    z = proj[..., :D_INNER].astype(jnp.float32)
    xbc = proj[..., D_INNER:D_INNER + SSD_CONV_DIM]
    dt_raw = proj[..., D_INNER + SSD_CONV_DIM:].astype(jnp.float32).reshape(b, L, 2, SSD_HEADS)
    xbc = jax.nn.silu(centred_depthwise_conv(xbc, conv_w, conv_b).astype(jnp.float32))
    xs = xbc[..., :D_INNER].reshape(b, L, SSD_HEADS, SSD_HEADDIM)
    bm = xbc[..., D_INNER:D_INNER + gn].reshape(b, L, SSD_GROUPS, SSD_STATE)
    cm = xbc[..., D_INNER + gn:].reshape(b, L, SSD_GROUPS, SSD_STATE)
    dt = jax.nn.softplus(dt_raw + dt_bias.astype(jnp.float32))
    a = -jnp.exp(a_log.astype(jnp.float32))
    y_f = ssd_chunked(xs, dt[:, :, 0], a[0], bm, cm)
    y_b = ssd_chunked(xs[:, ::-1], dt[:, ::-1, 1], a[1], bm[:, ::-1], cm[:, ::-1])[:, ::-1]
    y = y_f + y_b + xs * d_skip.astype(jnp.float32)[:, None]
    y = rms_norm_groups(y.reshape(b, L, D_INNER) * jax.nn.silu(z), norm_g, SSD_GROUPS)
    return (y.astype(x.dtype) @ w_out).astype(x.dtype)


def hgrn2_chunked(q, k, log_f, v):
    b, L, h, dk = q.shape
    dv = v.shape[-1]
    T = HG_CHUNK
    nc = L // T

    def to_chunks(a):
        return jnp.moveaxis(a.reshape(b, nc, T, h, a.shape[-1]), 1, 0)

    causal = jnp.tril(jnp.ones((T, T), dtype=bool))[None, :, :, None, None]

    def step(S, inp):
        qt, kt, gt, vt = inp
        G = jnp.cumsum(gt, axis=1)
        o_inter = jnp.einsum('bthk,bhkv->bthv', qt * jnp.exp(G), S)
        diff = G[:, :, None] - G[:, None, :]
        decay = jnp.exp(jnp.where(causal, diff, -jnp.inf))
        att = jnp.einsum('bthk,bshk,btshk->bhts', qt, kt, decay)
        o_intra = jnp.einsum('bhts,bshv->bthv', att, vt)
        g_last = G[:, -1]
        k_dec = kt * jnp.exp(g_last[:, None] - G)
        S_new = jnp.exp(g_last)[..., None] * S + jnp.einsum('bshk,bshv->bhkv', k_dec, vt)
        return S_new, o_inter + o_intra

    S0 = jnp.zeros((b, h, dk, dv), jnp.float32)
    _, o = lax.scan(step, S0, (to_chunks(q), to_chunks(k), to_chunks(log_f), to_chunks(v)))
    return jnp.moveaxis(o, 0, 1).reshape(b, L, h, dv)


def hgrn2_mixer(x, w_in, lb, norm_g, w_out):
    b, L, _ = x.shape
    F = HG_FDIM
    proj = (x @ w_in).astype(jnp.float32)
    q = proj[..., :F].reshape(b, L, HG_HEADS, HG_KEY_DIM)
    f_raw = proj[..., F:3 * F].reshape(b, L, 2, HG_HEADS, HG_KEY_DIM)
    v = proj[..., 3 * F:3 * F + D_INNER].reshape(b, L, HG_HEADS, HG_VAL_DIM)
    z = proj[..., 3 * F + D_INNER:]
    lb = lb.astype(jnp.float32).reshape(2, HG_HEADS, HG_KEY_DIM)
    log_f = jnp.logaddexp(jnp.log(lb), jnp.log1p(-lb) + jax.nn.log_sigmoid(f_raw))
    k = (1.0 - lb) * jax.nn.sigmoid(-f_raw)
    o_f = hgrn2_chunked(q, k[:, :, 0], log_f[:, :, 0], v)
    o_b = hgrn2_chunked(q[:, ::-1], k[:, ::-1, 1], log_f[:, ::-1, 1], v[:, ::-1])[:, ::-1]
    o = rms_norm_groups((o_f + o_b).reshape(b, L, D_INNER), norm_g, HG_HEADS) * jax.nn.silu(z)
    return (o.astype(x.dtype) @ w_out).astype(x.dtype)


def _normal(key, shape, scale):
    return jax.random.normal(key, shape, jnp.float32) * scale


def _ln_params(p, ks):
    return {p + "ln_g": 1.0 + _normal(next(ks), (D_MODEL,), 0.02),
            p + "ln_b": _normal(next(ks), (D_MODEL,), 0.02)}


def _hyena_params(p, ks):
    H = HY_FILTER_HIDDEN
    d = {
        p + "w_in": _normal(next(ks), (D_MODEL, HY_IN_DIM), D_MODEL ** -0.5),
        p + "conv_w": _normal(next(ks), (HY_SHORT_CONV, 3 * D_INNER), HY_SHORT_CONV ** -0.5),
        p + "conv_b": _normal(next(ks), (3 * D_INNER,), 0.02),
        p + "filt_w1": _normal(next(ks), (HY_EMB_DIM, H), HY_EMB_DIM ** -0.5),
        p + "filt_b1": _normal(next(ks), (H,), 0.02),
        p + "filt_w2": _normal(next(ks), (H, H), H ** -0.5),
        p + "filt_b2": _normal(next(ks), (H,), 0.02),
        p + "filt_w3": _normal(next(ks), (H, H), H ** -0.5),
        p + "filt_b3": _normal(next(ks), (H,), 0.02),
        p + "filt_freq": 1.0 + _normal(next(ks), (H,), 0.02),
        p + "filt_w_out": _normal(next(ks), (H, 2 * D_INNER), H ** -0.5),
        p + "skip": _normal(next(ks), (D_INNER,), 1.0),
        p + "w_out": _normal(next(ks), (D_INNER, D_MODEL), D_INNER ** -0.5 * DEEPNORM_BETA),
    }
    d.update(_ln_params(p, ks))
    return d


def _ssd_params(p, ks):
    log_dt = jax.random.uniform(next(ks), (2, SSD_HEADS), jnp.float32,
                                math.log(SSD_DT_MIN), math.log(SSD_DT_MAX))
    dt = jnp.exp(log_dt)
    d = {
        p + "w_in": _normal(next(ks), (D_MODEL, SSD_IN_DIM), D_MODEL ** -0.5),
        p + "conv_w": _normal(next(ks), (SSD_CONV, SSD_CONV_DIM), SSD_CONV ** -0.5),
        p + "conv_b": _normal(next(ks), (SSD_CONV_DIM,), 0.02),
        p + "dt_bias": dt + jnp.log(-jnp.expm1(-dt)),
        p + "a_log": jnp.log(jax.random.uniform(next(ks), (2, SSD_HEADS), jnp.float32, 1.0, 16.0)),
        p + "d_skip": 1.0 + _normal(next(ks), (SSD_HEADS,), 0.1),
        p + "norm_g": 1.0 + _normal(next(ks), (D_INNER,), 0.02),
        p + "w_out": _normal(next(ks), (D_INNER, D_MODEL), D_INNER ** -0.5 * DEEPNORM_BETA),
    }
    d.update(_ln_params(p, ks))
    return d


def _hgrn2_params(p, ks):
    d = {
        p + "w_in": _normal(next(ks), (D_MODEL, HG_IN_DIM), D_MODEL ** -0.5),
        p + "norm_g": 1.0 + _normal(next(ks), (D_INNER,), 0.02),
        p + "w_out": _normal(next(ks), (D_INNER, D_MODEL), D_INNER ** -0.5 * DEEPNORM_BETA),
    }
    d.update(_ln_params(p, ks))
    return d


def setup_inputs(seed: int = 0) -> dict:
    key = jax.random.key(seed)
    ks = iter(jax.random.split(key, 64))
    inputs = {
        "x": _normal(next(ks), (BATCH, SEQ, D_MODEL), 1.0),
        "hgrn_lower_bounds": _normal(next(ks), (DEPTH, 2 * HG_FDIM), 0.1),
    }
    inputs.update(_hyena_params("l0_", ks))
    inputs.update(_ssd_params("l1_", ks))
    inputs.update(_hgrn2_params("l2_", ks))
    inputs.update(_hyena_params("l3_", ks))
    return inputs


def reference(x, hgrn_lower_bounds,
              l0_w_in, l0_conv_w, l0_conv_b, l0_filt_w1, l0_filt_b1, l0_filt_w2, l0_filt_b2,
              l0_filt_w3, l0_filt_b3, l0_filt_freq, l0_filt_w_out, l0_skip, l0_w_out, l0_ln_g, l0_ln_b,
              l1_w_in, l1_conv_w, l1_conv_b, l1_dt_bias, l1_a_log, l1_d_skip, l1_norm_g, l1_w_out,
              l1_ln_g, l1_ln_b,
              l2_w_in, l2_norm_g, l2_w_out, l2_ln_g, l2_ln_b,
              l3_w_in, l3_conv_w, l3_conv_b, l3_filt_w1, l3_filt_b1, l3_filt_w2, l3_filt_b2,
              l3_filt_w3, l3_filt_b3, l3_filt_freq, l3_filt_w_out, l3_skip, l3_w_out, l3_ln_g, l3_ln_b):
    layer_params = [
        (l0_w_in, l0_conv_w, l0_conv_b, l0_filt_w1, l0_filt_b1, l0_filt_w2, l0_filt_b2,
         l0_filt_w3, l0_filt_b3, l0_filt_freq, l0_filt_w_out, l0_skip, l0_w_out),
        (l1_w_in, l1_conv_w, l1_conv_b, l1_dt_bias, l1_a_log, l1_d_skip, l1_norm_g, l1_w_out),
        (l2_w_in, l2_norm_g, l2_w_out),
        (l3_w_in, l3_conv_w, l3_conv_b, l3_filt_w1, l3_filt_b1, l3_filt_w2, l3_filt_b2,
         l3_filt_w3, l3_filt_b3, l3_filt_freq, l3_filt_w_out, l3_skip, l3_w_out),
    ]
    ln_params = [(l0_ln_g, l0_ln_b), (l1_ln_g, l1_ln_b), (l2_ln_g, l2_ln_b), (l3_ln_g, l3_ln_b)]
    lb_all = jnp.cumsum(jax.nn.softmax(hgrn_lower_bounds.astype(jnp.float32), axis=0), axis=0)
    lb_all = lb_all - lb_all[0]
    h = x
    for i in range(DEPTH):
        kind = i % N_MIXERS
        if kind == 0:
            y = hyena_mixer(h, *layer_params[i])
        elif kind == 1:
            y = ssd_mixer(h, *layer_params[i])
        else:
            w_in, norm_g, w_out = layer_params[i]
            y = hgrn2_mixer(h, w_in, lb_all[i], norm_g, w_out)
        h = layer_norm(DEEPNORM_ALPHA * h + y, *ln_params[i]).astype(x.dtype)
    return h
```

```cpp
#include <hip/hip_runtime.h>
#include <hip/hip_cooperative_groups.h>
#include <cstdio>
namespace cg = cooperative_groups;

typedef unsigned short bf16_t;
typedef short bf16x8 __attribute__((ext_vector_type(8)));
typedef float f32x16 __attribute__((ext_vector_type(16)));
typedef unsigned u32x4 __attribute__((ext_vector_type(4)));
#define DI __device__ __forceinline__
#define MFMA(a, b, c) __builtin_amdgcn_mfma_f32_32x32x16_bf16((a), (b), (c), 0, 0, 0)

#ifndef REP_GEMM
#define REP_GEMM 1
#endif
#ifndef REP_CONV
#define REP_CONV 1
#endif
#ifndef REP_SCAN
#define REP_SCAN 1
#endif
#ifndef REP_SYNC
#define REP_SYNC 1
#endif
#ifndef REP_HYEW
#define REP_HYEW 1
#endif
#ifndef REP_MISC
#define REP_MISC 1
#endif
#ifndef REP_EW2
#define REP_EW2 1
#endif
constexpr int NT = 512;
constexpr size_t LDS_BYTES = 158 * 1024;
constexpr int SEQ = 4096;
constexpr int MTOT = 32768;
constexpr int MH = 16384;
constexpr size_t MiB = 1024 * 1024;
constexpr size_t OFF_HB = 0;
constexpr size_t OFF_WTIN = 64 * MiB;
constexpr size_t OFF_WTOUT = 84 * MiB;
constexpr size_t OFF_KF = 90 * MiB;
constexpr size_t OFF_KB = 106 * MiB;
constexpr size_t OFF_PROJ = 122 * MiB;
constexpr size_t OFF_AUX = 378 * MiB;
constexpr size_t OFF_SSD_XBC = 286 * MiB;
constexpr size_t OFF_SSD_YF = 382 * MiB;
constexpr size_t OFF_SSD_YB = 446 * MiB;
constexpr size_t OFF_VT = 122 * MiB;
constexpr size_t OFF_PROJ2 = 250 * MiB;
constexpr size_t OFF_YBUF = 378 * MiB;
constexpr size_t OFF_BAR = 511 * MiB;
constexpr size_t WS_NEED = 512 * MiB;

struct Params {
  const float* in[47];
  float* out;
  char* ws;
};

DI float bf2f(bf16_t h) { return __uint_as_float(((unsigned)h) << 16); }
typedef __bf16 bf16x2_t __attribute__((ext_vector_type(2)));
typedef float f32x2_t __attribute__((ext_vector_type(2)));
DI unsigned pack2(float a, float b) { f32x2_t v = {a, b}; return __builtin_bit_cast(unsigned, __builtin_convertvector(v, bf16x2_t)); }
DI bf16_t f2bf(float x) { return (bf16_t)(pack2(x, 0.f) & 0xffffu); }
DI float lo2f(unsigned v) { return __uint_as_float(v << 16); }
DI float hi2f(unsigned v) { return __uint_as_float(v & 0xffff0000u); }
DI f32x16 zero16() { f32x16 z; for (int i = 0; i < 16; ++i) z[i] = 0.f; return z; }
DI bf16x8 ldfrag(const bf16_t* p) { return *(const bf16x8*)p; }
DI float silu(float x) { return x * __builtin_amdgcn_rcpf(1.f + __expf(-x)); }
DI int opaque_tid(int wvs) {
  int l; asm volatile("v_mbcnt_lo_u32_b32 %0, -1, 0\n\tv_mbcnt_hi_u32_b32 %0, -1, %0" : "=v"(l));
  return (wvs << 6) | l; }
DI float wave_sum(float v) { for (int o = 32; o >= 1; o >>= 1) v += __shfl_xor(v, o); return v; }


#define XB_TMO      128
#define XB_XCNT(j)  (256  + 64 * (j))
#define XB_XSUB(j)  (1280 + 64 * (j))
#define XB_XGEN(j)  (2304 + 64 * (j))
#define XB_TOP      3328
#define XB_TOPGEN   3392
#define XCD_BAR_WORDS 3456
#define XB_SPIN_CAP (1u << 18)
#define LAS __attribute__((address_space(3)))
__device__ __forceinline__ unsigned xb_ld(unsigned* p)              { return __hip_atomic_load(p, __ATOMIC_RELAXED, __HIP_MEMORY_SCOPE_AGENT); }
__device__ __forceinline__ unsigned xb_add(unsigned* p, unsigned v) { return __hip_atomic_fetch_add(p, v, __ATOMIC_RELAXED, __HIP_MEMORY_SCOPE_AGENT); }
__device__ __forceinline__ unsigned xb_xcc_id() { return (unsigned)__builtin_amdgcn_s_getreg((3 << 11) | 20) & 0xFu; }
#define XB_SPIN(cond, bar) do { unsigned _sp = 0; while (cond) { __builtin_amdgcn_s_sleep(1); \
    if ((++_sp & 255u) == 0u) { if (xb_ld(&(bar)[XB_TMO])) break; if (_sp > XB_SPIN_CAP) { atomicAdd(&(bar)[XB_TMO], 1u); break; } } } } while (0)

struct XcdBarrier {
    unsigned* bar; unsigned x; int wvs;
    volatile LAS unsigned* st;
};

__device__ __forceinline__ bool xb_is_t0(int wvs) { int l; asm volatile("v_mbcnt_lo_u32_b32 %0, -1, 0\n\tv_mbcnt_hi_u32_b32 %0, -1, %0" : "=v"(l)); return wvs == 0 && l == 0; }
__device__ __forceinline__ XcdBarrier xcd_barrier_post(unsigned* bar, volatile LAS unsigned* st, int wvs) {
    XcdBarrier b; b.bar = bar; b.x = xb_xcc_id(); b.st = st; b.wvs = wvs;
    if (xb_is_t0(b.wvs)) (void)xb_add(&bar[XB_XCNT(b.x)], 1u);
    return b;
}
__device__ __forceinline__ void xcd_barrier_complete(unsigned* bar, unsigned x, unsigned& nloc, unsigned& nx) {
    const unsigned G = gridDim.x * gridDim.y * gridDim.z;
    unsigned sum, cnt, mine, sp = 0u;
    for (;;) {
        sum = 0u; cnt = 0u; mine = 0u;
#pragma unroll
        for (unsigned j = 0; j < 16; ++j) { const unsigned c = xb_ld(&bar[XB_XCNT(j)]); sum += c; cnt += (c > 0u) ? 1u : 0u; mine = (j == x) ? c : mine; }
        if (sum == G) break;
        __builtin_amdgcn_s_sleep(1);
        if ((++sp & 255u) == 0u) { if (xb_ld(&bar[XB_TMO])) break; if (sp > XB_SPIN_CAP) { atomicAdd(&bar[XB_TMO], 1u); break; } }
    }
    nloc = mine > 0u ? mine : 1u; nx = cnt > 0u ? cnt : 1u;
}

__device__ __forceinline__ void xcd_barrier(const XcdBarrier& b) {
    asm volatile("s_waitcnt vmcnt(0)" ::: "memory");
    __syncthreads();
    if (xb_is_t0(b.wvs)) {
        unsigned* bar = b.bar;
        __builtin_amdgcn_s_waitcnt(0);
        unsigned nloc = b.st[0], nx = b.st[1];
        if (nloc == 0u) { xcd_barrier_complete(bar, b.x, nloc, nx); b.st[0] = nloc; b.st[1] = nx; }
        const unsigned old = xb_add(&bar[XB_XSUB(b.x)], 1u);
        const unsigned gen = old / nloc;
        if (old + 1u == (gen + 1u) * nloc) {
            __builtin_amdgcn_fence(__ATOMIC_RELEASE, "agent");
            asm volatile("s_waitcnt vmcnt(0)" ::: "memory");
            const unsigned og = xb_add(&bar[XB_TOP], 1u);
            const unsigned tg = og / nx;
            if (og + 1u == (tg + 1u) * nx) xb_add(&bar[XB_TOPGEN], 1u);
            else XB_SPIN(xb_ld(&bar[XB_TOPGEN]) == tg, bar);
            __builtin_amdgcn_fence(__ATOMIC_ACQUIRE, "agent");
            xb_add(&bar[XB_XGEN(b.x)], 1u);
            asm volatile("s_waitcnt vmcnt(0)" ::: "memory");
        } else {
            XB_SPIN(xb_ld(&bar[XB_XGEN(b.x)]) == gen, bar);
            __builtin_amdgcn_fence(__ATOMIC_ACQUIRE, "agent");
            asm volatile("s_waitcnt vmcnt(0)" ::: "memory");
        }
    }
    __syncthreads();
}

template <int MODE, int LMPX>
DI void gemm_phase(int wvs, char* smem, const bf16_t* __restrict__ A, int lda, const bf16_t* __restrict__ Wt, int K, int Mtiles, int Ntiles,
                   bf16_t* C, int ldc, const bf16_t* res, bf16_t* outp, float alpha, bool dostore = true, int nvalid = 1 << 30) {
  constexpr int BUFB = 65536;
  const int tid = opaque_tid(wvs), lane = tid & 63, w = tid >> 6, r = lane & 31, hh = lane >> 5;
  const int wm = w >> 1, wn = w & 1;
  const int xcd = blockIdx.x & 7, slot = blockIdx.x >> 3;
  constexpr int mpx = 1 << LMPX, nslots = 32;
  const int ntx = mpx * Ntiles, nk = K / 64, lnk = (nk == 16) ? 4 : 5;
  if (slot >= ntx) return;
  const int nmine = (ntx - slot + nslots - 1) / nslots;
  const int S = nmine * nk;
  const bool sq = (Ntiles & 7) == 0;
#define G_TILEMAP(q, MT, NT) do { if (sq) { const int grp_ = (q) >> 5, i_ = (q) & 31; \
      MT = xcd * mpx + (grp_ & (mpx / 4 - 1)) * 4 + (i_ & 3); NT = (grp_ >> (LMPX - 2)) * 8 + (i_ >> 2); } \
    else { MT = xcd * mpx + ((q) & (mpx - 1)); NT = (q) >> LMPX; } } while (0)
  const int drr = lane >> 3, dch = (lane & 7) ^ (((w & 1) * 4 + (drr >> 1)) & 7);
  const int drow = w * 8 + drr, dcol = dch * 8;
  const unsigned dA = (unsigned)(drow * lda + dcol), dB = (unsigned)(drow * K + dcol);
#define G_DMA(s0, bufbyte) do { const int s_ = ((s0) < S) ? (s0) : S - 1; \
    const int q_ = slot + (s_ >> lnk) * nslots, kt_ = s_ & (nk - 1); \
    int mt_, nt_; G_TILEMAP(q_, mt_, nt_); \
    const char* Ab_ = (const char*)(A + (size_t)(mt_ * 256) * lda + kt_ * 64);     \
    const char* Bb_ = (const char*)(Wt + (size_t)(nt_ * 256) * K + kt_ * 64); \
    char* L_ = smem + (bufbyte) + w * 1024; \
    _Pragma("unroll") for (int j_ = 0; j_ < 4; ++j_) \
      __builtin_amdgcn_global_load_lds((const unsigned*)(Ab_ + (size_t)(128 * j_) * lda + (2u * dA)), (__attribute__((address_space(3))) unsigned*)(L_ + j_ * 8192), 16, 0, 0); \
    _Pragma("unroll") for (int j_ = 0; j_ < 4; ++j_) \
      __builtin_amdgcn_global_load_lds((const unsigned*)(Bb_ + (size_t)(128 * j_) * K + (2u * dB)), (__attribute__((address_space(3))) unsigned*)(L_ + 32768 + j_ * 8192), 16, 0, 0); } while (0)
  const int fP = r * 128, fsw = (r >> 1) & 7;
  const int fA = wm * 8192 + fP, fB = 32768 + wn * 16384 + fP;
  f32x16 acc[2][4];
#pragma unroll
  for (int i = 0; i < 2; ++i)
#pragma unroll
    for (int j = 0; j < 4; ++j) acc[i][j] = zero16();
  __syncthreads();
  G_DMA(0, 0);
  asm volatile("s_waitcnt vmcnt(0)" ::: "memory");
  asm volatile("s_waitcnt lgkmcnt(0)" ::: "memory"); __builtin_amdgcn_s_barrier(); asm volatile("" ::: "memory");
  int cur = 0;
  for (int s = 0; s < S; ++s) {
    G_DMA(s + 1, cur ^ BUFB);
    {
      const char* Ab = smem + cur + fA;
      const char* Bb = smem + cur + fB;
      __builtin_amdgcn_sched_barrier(0);
#pragma unroll
      for (int kk = 0; kk < 4; ++kk) {
        const int ko = (((kk * 2 + hh) ^ fsw) << 4);
        bf16x8 af[2], wf[4];
        af[0] = *(const bf16x8*)(Ab + ko); af[1] = *(const bf16x8*)(Ab + 4096 + ko);
#pragma unroll
        for (int ni = 0; ni < 4; ++ni) wf[ni] = *(const bf16x8*)(Bb + ni * 4096 + ko);
#pragma unroll
        for (int mi = 0; mi < 2; ++mi)
#pragma unroll
          for (int ni = 0; ni < 4; ++ni) acc[mi][ni] = MFMA(wf[ni], af[mi], acc[mi][ni]);
        if (kk == 1) __builtin_amdgcn_sched_barrier(0);
      }
      __builtin_amdgcn_sched_barrier(0);
    }
    asm volatile("s_waitcnt vmcnt(0)" ::: "memory");
    if ((s & (nk - 1)) == nk - 1) {
      const int q = slot + (s >> lnk) * nslots;
      int mt, nt; G_TILEMAP(q, mt, nt);
      if (dostore) {
#pragma unroll
        for (int mi = 0; mi < 2; ++mi) {
          const size_t m = (size_t)mt * 256 + wm * 64 + mi * 32 + r;
#pragma unroll
          for (int ni = 0; ni < 4; ++ni) {
            __builtin_amdgcn_sched_barrier(0);
            if (MODE == 0) {
#pragma unroll
              for (int gp = 0; gp < 2; ++gp) {
                const int g0 = 2 * gp;
                uint2 pa, pb;
                pa.x = pack2(acc[mi][ni][4 * g0], acc[mi][ni][4 * g0 + 1]); pa.y = pack2(acc[mi][ni][4 * g0 + 2], acc[mi][ni][4 * g0 + 3]);
                pb.x = pack2(acc[mi][ni][4 * g0 + 4], acc[mi][ni][4 * g0 + 5]); pb.y = pack2(acc[mi][ni][4 * g0 + 6], acc[mi][ni][4 * g0 + 7]);
                { auto rx = __builtin_amdgcn_permlane32_swap(pa.x, pb.x, false, false); pa.x = rx[0]; pb.x = rx[1]; }
                { auto ry = __builtin_amdgcn_permlane32_swap(pa.y, pb.y, false, false); pa.y = ry[0]; pb.y = ry[1]; }
                const int col = nt * 256 + wn * 128 + ni * 32 + 8 * g0 + 8 * hh;
                const uint4 v4 = make_uint4(pa.x, pa.y, pb.x, pb.y);
                if (outp != nullptr && nt >= 32) *(uint4*)(outp + m * 2048 + (col - 8192)) = v4;
                else if (col < nvalid) *(uint4*)(C + m * ldc + col) = v4;
              }
            } else if (MODE == 1) {
#pragma unroll
              for (int gp = 0; gp < 2; ++gp) {
                const int g0 = 2 * gp;
                const int nb_ = nt * 256 + wn * 128 + ni * 32 + 8 * g0;
                const uint2 ra = *(const uint2*)(res + m * 1024 + nb_ + 4 * hh), rb = *(const uint2*)(res + m * 1024 + nb_ + 8 + 4 * hh);
                uint2 pa, pb;
                pa.x = pack2(alpha * lo2f(ra.x) + acc[mi][ni][4 * g0], alpha * hi2f(ra.x) + acc[mi][ni][4 * g0 + 1]);
                pa.y = pack2(alpha * lo2f(ra.y) + acc[mi][ni][4 * g0 + 2], alpha * hi2f(ra.y) + acc[mi][ni][4 * g0 + 3]);
                pb.x = pack2(alpha * lo2f(rb.x) + acc[mi][ni][4 * g0 + 4], alpha * hi2f(rb.x) + acc[mi][ni][4 * g0 + 5]);
                pb.y = pack2(alpha * lo2f(rb.y) + acc[mi][ni][4 * g0 + 6], alpha * hi2f(rb.y) + acc[mi][ni][4 * g0 + 7]);
                { auto rx = __builtin_amdgcn_permlane32_swap(pa.x, pb.x, false, false); pa.x = rx[0]; pb.x = rx[1]; }
                { auto ry = __builtin_amdgcn_permlane32_swap(pa.y, pb.y, false, false); pa.y = ry[0]; pb.y = ry[1]; }
                *(uint4*)(outp + m * 1024 + nb_ + 8 * hh) = make_uint4(pa.x, pa.y, pb.x, pb.y);
              }
            } else
#pragma unroll
            for (int g = 0; g < 4; ++g) {
              const int n = nt * 256 + wn * 128 + ni * 32 + 8 * g + 4 * hh;
              const float a0 = acc[mi][ni][4 * g], a1 = acc[mi][ni][4 * g + 1], a2 = acc[mi][ni][4 * g + 2], a3 = acc[mi][ni][4 * g + 3];
              if (MODE == 0) {
                uint2 pk; pk.x = pack2(a0, a1); pk.y = pack2(a2, a3);
                if (outp != nullptr && nt >= 32) *(uint2*)(outp + m * 2048 + (n - 8192)) = pk;
                else if (n < nvalid) *(uint2*)(C + m * ldc + n) = pk;
              } else if (MODE == 2) {
                const unsigned p01 = pack2(a0, a1), p23 = pack2(a2, a3);
                const unsigned q01 = (unsigned)__builtin_amdgcn_update_dpp(0, (int)p01, 0xB1, 0xF, 0xF, true);
                const unsigned q23 = (unsigned)__builtin_amdgcn_update_dpp(0, (int)p23, 0xB1, 0xF, 0xF, true);
                const bool odd = (r & 1) != 0;
                const unsigned o01 = odd ? ((q01 >> 16) | (p01 & 0xffff0000u)) : ((p01 & 0xffffu) | (q01 << 16));
                const unsigned o23 = odd ? ((q23 >> 16) | (p23 & 0xffff0000u)) : ((p23 & 0xffffu) | (q23 << 16));
                bf16_t* dst = ((nt < 8) ? C : outp) + ((size_t)((n + (odd ? 1 : 0)) & 2047) * 8 + (m >> 12)) * SEQ + ((m & 4095) & ~(size_t)1);
                *(unsigned*)dst = o01;
                *(unsigned*)(dst + (size_t)16 * SEQ) = o23;
              } else {
                const uint2 rs = *(const uint2*)(res + m * 1024 + n);
                uint2 pk; pk.x = pack2(alpha * lo2f(rs.x) + a0, alpha * hi2f(rs.x) + a1); pk.y = pack2(alpha * lo2f(rs.y) + a2, alpha * hi2f(rs.y) + a3);
                *(uint2*)(outp + m * 1024 + n) = pk;
              }
            }
          }
        }
      }
#pragma unroll
      for (int i = 0; i < 2; ++i)
#pragma unroll
        for (int j = 0; j < 4; ++j) acc[i][j] = zero16();
    }
    asm volatile("s_waitcnt lgkmcnt(0)" ::: "memory"); __builtin_amdgcn_s_barrier(); asm volatile("" ::: "memory");
    cur ^= BUFB;
  }
  asm volatile("s_waitcnt vmcnt(0)" ::: "memory");
  __syncthreads();
#undef G_DMA
#undef G_TILEMAP
}

DI void wtrans_phase(int wvs, char* smem, const float* __restrict__ W, int K, int ldw, int col0, int ncols, int Npad, bf16_t* Wt) {
  float* tile = (float*)smem;
  const int tid = opaque_tid(wvs);
  const int nkt = K / 64, nnt = Npad / 64;
  for (int it = blockIdx.x; it < nkt * nnt; it += gridDim.x) {
    const int kt = it % nkt, nt = it / nkt;
    __syncthreads();
#pragma unroll
    for (int i = 0; i < 8; ++i) {
      const int k = i * 8 + (tid >> 6), n = tid & 63, gn = nt * 64 + n;
      tile[k * 65 + n] = gn < ncols ? W[(size_t)(kt * 64 + k) * ldw + col0 + gn] : 0.f;
    }
    __syncthreads();
    const int n = tid >> 3, k8 = (tid & 7) * 8;
    u32x4 o;
    o[0] = pack2(tile[(k8 + 0) * 65 + n], tile[(k8 + 1) * 65 + n]);
    o[1] = pack2(tile[(k8 + 2) * 65 + n], tile[(k8 + 3) * 65 + n]);
    o[2] = pack2(tile[(k8 + 4) * 65 + n], tile[(k8 + 5) * 65 + n]);
    o[3] = pack2(tile[(k8 + 6) * 65 + n], tile[(k8 + 7) * 65 + n]);
    *(u32x4*)(Wt + (size_t)(nt * 64 + n) * K + kt * 64 + k8) = o;
  }
}

DI void ln_phase(int wvs, bf16_t* HB, const float* __restrict__ g, const float* __restrict__ bta, float* fout, bool dostore = true) {
  const int tid = opaque_tid(wvs);
  const int lane = tid & 63, w = tid >> 6;
  for (int row = blockIdx.x * 8 + w; row < MTOT; row += gridDim.x * 8) {
    bf16_t* p = HB + (size_t)row * 1024;
    float v[16];
    float s = 0.f;
#pragma unroll
    for (int i = 0; i < 2; ++i) {
      const u32x4 raw = *(const u32x4*)(p + i * 512 + lane * 8);
#pragma unroll
      for (int j = 0; j < 4; ++j) { v[i * 8 + 2 * j] = lo2f(raw[j]); v[i * 8 + 2 * j + 1] = hi2f(raw[j]); }
    }
#pragma unroll
    for (int i = 0; i < 16; ++i) s += v[i];
    const float mean = wave_sum(s) * (1.f / 1024.f);
    float q = 0.f;
#pragma unroll
    for (int i = 0; i < 16; ++i) { v[i] -= mean; q += v[i] * v[i]; }
    const float rstd = rsqrtf(wave_sum(q) * (1.f / 1024.f) + 1e-5f);
#pragma unroll
    for (int i = 0; i < 2; ++i) {
      const int c = i * 512 + lane * 8;
      const float4 g0 = *(const float4*)(g + c), g1 = *(const float4*)(g + c + 4), b0 = *(const float4*)(bta + c), b1 = *(const float4*)(bta + c + 4);
      float o[8];
      o[0] = v[i * 8 + 0] * rstd * g0.x + b0.x; o[1] = v[i * 8 + 1] * rstd * g0.y + b0.y; o[2] = v[i * 8 + 2] * rstd * g0.z + b0.z; o[3] = v[i * 8 + 3] * rstd * g0.w + b0.w;
      o[4] = v[i * 8 + 4] * rstd * g1.x + b1.x; o[5] = v[i * 8 + 5] * rstd * g1.y + b1.y; o[6] = v[i * 8 + 6] * rstd * g1.z + b1.z; o[7] = v[i * 8 + 7] * rstd * g1.w + b1.w;
      if (dostore) {
        u32x4 pk; pk[0] = pack2(o[0], o[1]); pk[1] = pack2(o[2], o[3]); pk[2] = pack2(o[4], o[5]); pk[3] = pack2(o[6], o[7]);
        *(u32x4*)(p + c) = pk;
        if (fout) {
          *(float4*)(fout + (size_t)row * 1024 + c) = make_float4(o[0], o[1], o[2], o[3]);
          *(float4*)(fout + (size_t)row * 1024 + c + 4) = make_float4(o[4], o[5], o[6], o[7]);
        }
      }
    }
  }
}

DI void cvt_phase(int wvs, const float* __restrict__ x, bf16_t* HB) {
  const int tid = opaque_tid(wvs);
  const size_t n4 = (size_t)MTOT * 1024 / 4;
  for (size_t i = (size_t)blockIdx.x * NT + tid; i < n4; i += (size_t)gridDim.x * NT) {
    const float4 v = *(const float4*)(x + i * 4);
    uint2 pk; pk.x = pack2(v.x, v.y); pk.y = pack2(v.z, v.w);
    *(uint2*)(HB + i * 4) = pk;
  }
}

DI bf16x8 pack8f(const float* v) {
  u32x4 o; o[0] = pack2(v[0], v[1]); o[1] = pack2(v[2], v[3]); o[2] = pack2(v[4], v[5]); o[3] = pack2(v[6], v[7]);
  return __builtin_bit_cast(bf16x8, o);
}
DI bf16x8 ldfrag_perm(const bf16_t* p) {
  const uint2 lo = *(const uint2*)p, hi = *(const uint2*)(p + 8);
  u32x4 o; o[0] = lo.x; o[1] = lo.y; o[2] = hi.x; o[3] = hi.y;
  return __builtin_bit_cast(bf16x8, o);
}
DI void hy_dense(const float* src, int nin, int sstride, const float* __restrict__ W, const float* __restrict__ bias,
                 const float* __restrict__ freq, float* dst, int tid) {
  const int u = tid & 63, p0 = tid >> 6;
  const float bb = bias[u], fr = freq[u];
  float s[8];
#pragma unroll
  for (int i = 0; i < 8; ++i) s[i] = bb;
#pragma unroll 4
  for (int f = 0; f < nin; ++f) {
    const float wv = W[f * 64 + u];
#pragma unroll
    for (int i = 0; i < 8; ++i) s[i] += src[(p0 + 8 * i) * sstride + f] * wv;
  }
#pragma unroll
  for (int i = 0; i < 8; ++i) dst[(p0 + 8 * i) * 64 + u] = sinf(fr * s[i]);
}

DI void hy_filter_phase(int wvs, char* smem, const float* __restrict__ w1, const float* __restrict__ b1, const float* __restrict__ w2,
                        const float* __restrict__ b2, const float* __restrict__ w3, const float* __restrict__ b3,
                        const float* __restrict__ freq, const float* __restrict__ wout, const float* __restrict__ skip,
                        bf16_t* KF, bf16_t* KB) {
  float* zf = (float*)smem;
  float* hA = zf + 64 * 33;
  float* hB = hA + 64 * 64;
  const int tid = opaque_tid(wvs);
  for (int it = blockIdx.x; it < 512; it += gridDim.x) {
    const int pb = it & 63, cgp = it >> 6;
    __syncthreads();
    for (int e = tid; e < 64 * 33; e += NT) {
      const int pos = e / 33, f = e % 33, t = pb * 64 + pos;
      float val;
      if (f == 0) val = (float)t / 4095.f;
      else {
        const int kb = (f - 1) & 15;
        const float fk = 1e-4f + (float)kb * ((15.f - 1e-4f) / 15.f);
        const float wt = 6.283185307179586f * (float)t / 4096.f;
        val = (f <= 16) ? cosf(fk * wt) : -sinf(fk * wt);
      }
      zf[e] = val;
    }
    __syncthreads();
    hy_dense(zf, 33, 33, w1, b1, freq, hA, tid);
    __syncthreads();
    hy_dense(hA, 64, 64, w2, b2, freq, hB, tid);
    __syncthreads();
    hy_dense(hB, 64, 64, w3, b3, freq, hA, tid);
    __syncthreads();
    {
      const int cc = cgp * 512 + tid, c = cc & 2047;
      float wc[64];
#pragma unroll
      for (int k = 0; k < 64; ++k) wc[k] = wout[(size_t)k * 4096 + cc];
      const float min_d = -15.350567286626973f, max_d = -3.0701134573253945f;
      const float delta = fabsf(min_d + (float)c * ((max_d - min_d) / 2047.f));
      bf16_t* dst = (cc < 2048 ? KF : KB) + (size_t)c * 4096 + pb * 64;
      const float sk = (cc < 2048) ? skip[c] : 0.f;
#pragma unroll 1
      for (int pp = 0; pp < 32; ++pp) {
        float s0 = 0.f, s1 = 0.f;
#pragma unroll
        for (int k4 = 0; k4 < 16; ++k4) {
          const float4 h0 = *(const float4*)(hA + (2 * pp) * 64 + k4 * 4);
          const float4 h1 = *(const float4*)(hA + (2 * pp + 1) * 64 + k4 * 4);
          s0 += h0.x * wc[4 * k4] + h0.y * wc[4 * k4 + 1] + h0.z * wc[4 * k4 + 2] + h0.w * wc[4 * k4 + 3];
          s1 += h1.x * wc[4 * k4] + h1.y * wc[4 * k4 + 1] + h1.z * wc[4 * k4 + 2] + h1.w * wc[4 * k4 + 3];
        }
        const int t = pb * 64 + 2 * pp;
        s0 *= expf(-((float)t / 4095.f) * delta);
        s1 *= expf(-((float)(t + 1) / 4095.f) * delta);
        if (t == 0) s0 += sk;
        *(unsigned*)(dst + 2 * pp) = pack2(s0, s1);
      }
    }
  }
}

DI void unpack8(const u32x4 v, float* f) {
#pragma unroll
  for (int j = 0; j < 4; ++j) { f[2 * j] = lo2f(v[j]); f[2 * j + 1] = hi2f(v[j]); }
}
DI void hy_conv_phase(int wvs, char* smem, bf16_t* X1T, const bf16_t* __restrict__ VT, const float* __restrict__ cw, const float* __restrict__ cb,
                      const bf16_t* __restrict__ KF, const bf16_t* __restrict__ KB, bool dostore = true) {
  bf16_t* Uimg = (bf16_t*)smem;
  bf16_t* R0 = Uimg + 512 * 72;
  bf16_t* R1 = R0 + 8192;
  const int tid = opaque_tid(wvs), lane = tid & 63, w = tid >> 6, n = lane & 31, hh = lane >> 5;
  for (int c = blockIdx.x; c < 2048; c += gridDim.x) {
    const float xa = cw[2048 + c], xb = cw[6144 + 2048 + c], xc = cw[12288 + 2048 + c], xbias = cb[2048 + c];
    const float va = cw[4096 + c], vb = cw[6144 + 4096 + c], vc = cw[12288 + 4096 + c], vbias = cb[4096 + c];
    const bf16_t* xrow = X1T + (size_t)c * 8 * SEQ;
    const bf16_t* vrow = VT + (size_t)c * 8 * SEQ;
    __syncthreads();
#pragma unroll 2
    for (int i = 0; i < 8; ++i) {
      const int e = tid + NT * i, b = e >> 9, t8 = (e & 511) * 8;
      const bf16_t* xp_ = xrow + b * SEQ + t8;
      const bf16_t* vp_ = vrow + b * SEQ + t8;
      const u32x4 xv = *(const u32x4*)xp_, vv = *(const u32x4*)vp_;
      float fx[10], fv[10];
      fx[0] = t8 > 0 ? bf2f(xp_[-1]) : 0.f; fv[0] = t8 > 0 ? bf2f(vp_[-1]) : 0.f;
      fx[9] = t8 + 8 < SEQ ? bf2f(xp_[8]) : 0.f; fv[9] = t8 + 8 < SEQ ? bf2f(vp_[8]) : 0.f;
      unpack8(xv, fx + 1); unpack8(vv, fv + 1);
      float u[8];
#pragma unroll
      for (int j = 0; j < 8; ++j)
        u[j] = (fx[j] * xa + fx[j + 1] * xb + fx[j + 2] * xc + xbias) * (fv[j] * va + fv[j + 1] * vb + fv[j + 2] * vc + vbias);
      *(bf16x8*)(Uimg + ((t8 >> 6) * 8 + b) * 72 + (t8 & 63)) = pack8f(u);
    }
    {
      const int t8 = tid * 8;
      const u32x4 vf = *(const u32x4*)(KF + (size_t)c * SEQ + t8);
      const u32x4 vb2 = *(const u32x4*)(KB + (size_t)c * SEQ + t8);
#pragma unroll
      for (int j = 0; j < 8; ++j) {
        const bf16_t hfv = (bf16_t)((j & 1) ? (vf[j >> 1] >> 16) : (vf[j >> 1] & 0xffffu));
        const bf16_t hbv = (bf16_t)((j & 1) ? (vb2[j >> 1] >> 16) : (vb2[j >> 1] & 0xffffu));
        const int tt = t8 + j;
        const int y = 4095 - tt;
        R0[y] = hfv;
        if (y >= 1) R1[y - 1] = hfv;
        if (tt >= 1) { const int y2 = 4095 + tt; R0[y2] = hbv; R1[y2 - 1] = hbv; }
      }
      if (tid == 0) { R0[8191] = 0; R1[8190] = 0; R1[8191] = 0; }
    }
    __syncthreads();
    const int b = n & 7, t1a = 8 * w + (n >> 3);
    const bf16_t* Rb = (n & 1) ? R0 : (R1 - 1);
    f32x16 acc00 = zero16(), acc01 = zero16(), acc10 = zero16(), acc11 = zero16();
    bf16x8 carry0, carry1;
    {
      const int yb0 = 4095 - 64 * (8 * w - 63) - n + 8 * hh;
      const unsigned* p0 = (const unsigned*)(Rb + yb0 + 32);
      const unsigned* p1 = (const unsigned*)(Rb + yb0 + 48);
      u32x4 a0, a1;
      a0[0] = p0[0]; a0[1] = p0[1]; a0[2] = p0[2]; a0[3] = p0[3];
      a1[0] = p1[0]; a1[1] = p1[1]; a1[2] = p1[2]; a1[3] = p1[3];
      carry0 = __builtin_bit_cast(bf16x8, a0); carry1 = __builtin_bit_cast(bf16x8, a1);
    }
    for (int d1 = 8 * w - 63; d1 <= 8 * w + 7; ++d1) {
      const int s1a = t1a - d1, s1b = s1a + 4;
      const bool va_ = (s1a >= 0) && (s1a < 64), vb_ = (s1b >= 0) && (s1b < 64);
      const bf16_t* urow0 = Uimg + ((va_ ? s1a : 0) * 8 + b) * 72 + 8 * hh;
      const bf16_t* urow1 = Uimg + ((vb_ ? s1b : 0) * 8 + b) * 72 + 8 * hh;
      const int ybase = 4095 - 64 * d1 - n + 8 * hh;
      bf16x8 b0[4], b1[4], af0[4], af1[4];
      __builtin_amdgcn_sched_barrier(0);
#pragma unroll
      for (int ks = 0; ks < 4; ++ks) {
        b0[ks] = ldfrag(urow0 + ks * 16); b1[ks] = ldfrag(urow1 + ks * 16);
        if (ks < 2) {
          const unsigned* p0 = (const unsigned*)(Rb + ybase + 16 * ks);
          const unsigned* p1 = (const unsigned*)(Rb + ybase + 16 * ks - 32);
          u32x4 a0, a1;
          a0[0] = p0[0]; a0[1] = p0[1]; a0[2] = p0[2]; a0[3] = p0[3];
          a1[0] = p1[0]; a1[1] = p1[1]; a1[2] = p1[2]; a1[3] = p1[3];
          af0[ks] = __builtin_bit_cast(bf16x8, a0); af1[ks] = __builtin_bit_cast(bf16x8, a1);
        }
      }
      af0[2] = carry0; af0[3] = carry1; af1[2] = af0[0]; af1[3] = af0[1];
      carry0 = af1[0]; carry1 = af1[1];
      if (!va_) {
#pragma unroll
        for (int ks = 0; ks < 4; ++ks) for (int j = 0; j < 8; ++j) b0[ks][j] = 0;
      }
      if (!vb_) {
#pragma unroll
        for (int ks = 0; ks < 4; ++ks) for (int j = 0; j < 8; ++j) b1[ks][j] = 0;
      }
      __builtin_amdgcn_sched_barrier(0);
#pragma unroll
      for (int ks = 0; ks < 4; ++ks) {
        acc00 = MFMA(af0[ks], b0[ks], acc00); acc01 = MFMA(af1[ks], b0[ks], acc01);
        acc10 = MFMA(af0[ks], b1[ks], acc10); acc11 = MFMA(af1[ks], b1[ks], acc11);
      }
      __builtin_amdgcn_sched_barrier(0);
    }
    if (dostore) {
      bf16_t* dst0 = X1T + ((size_t)c * 8 + b) * SEQ + 64 * t1a + 8 * hh;
      bf16_t* dst1 = dst0 + 64 * 4;
#define CV_STORE(ACC, DST) do { \
      _Pragma("unroll") for (int gp = 0; gp < 2; ++gp) { const int g0 = 2 * gp; \
        uint2 pa, pb; \
        pa.x = pack2(ACC[4 * g0], ACC[4 * g0 + 1]); pa.y = pack2(ACC[4 * g0 + 2], ACC[4 * g0 + 3]); \
        pb.x = pack2(ACC[4 * g0 + 4], ACC[4 * g0 + 5]); pb.y = pack2(ACC[4 * g0 + 6], ACC[4 * g0 + 7]); \
        { auto rx = __builtin_amdgcn_permlane32_swap(pa.x, pb.x, false, false); pa.x = rx[0]; pb.x = rx[1]; } \
        { auto ry = __builtin_amdgcn_permlane32_swap(pa.y, pb.y, false, false); pa.y = ry[0]; pb.y = ry[1]; } \
        *(uint4*)((DST) + 8 * g0) = make_uint4(pa.x, pa.y, pb.x, pb.y); } } while (0)
      CV_STORE(acc00, dst0);
      CV_STORE(acc01, dst0 + 32);
      CV_STORE(acc10, dst1);
      CV_STORE(acc11, dst1 + 32);
#undef CV_STORE
    }
  }
}

DI void hy_post_phase(int wvs, char* smem, const bf16_t* __restrict__ PROJ2, const float* __restrict__ cw, const float* __restrict__ cb,
                      const bf16_t* __restrict__ Yt, bf16_t* YBUF, int half) {
  bf16_t* tile = (bf16_t*)smem;
  const int tid = opaque_tid(wvs);
  const int c8 = tid & 7, tl = tid >> 3;
  const int ct = blockIdx.x & 31, c0 = ct * 64 + c8 * 8;
  float wx[3][8], bx[8];
#pragma unroll
  for (int j = 0; j < 3; ++j)
#pragma unroll
    for (int e = 0; e < 8; ++e) wx[j][e] = cw[j * 6144 + c0 + e];
#pragma unroll
  for (int e = 0; e < 8; ++e) bx[e] = cb[c0 + e];
  const u32x4 zero4 = {0u, 0u, 0u, 0u};
  for (int j = blockIdx.x >> 5; j < 256; j += gridDim.x >> 5) {
    const int b = j >> 6, tt = j & 63;
    const int t = tt * 64 + tl;
    const bf16_t* p = PROJ2 + (size_t)(b * SEQ + t) * 4096 + c0;
    const u32x4 x0 = *(const u32x4*)(p), zz = *(const u32x4*)(p + 2048);
    const u32x4 xm = t > 0 ? *(const u32x4*)(p - 4096) : zero4;
    const u32x4 xp = t < SEQ - 1 ? *(const u32x4*)(p + 4096) : zero4;
    __syncthreads();
    {
      const int c2 = tid >> 3, t8 = (tid & 7) * 8;
      const u32x4 v = *(const u32x4*)(Yt + ((size_t)(ct * 64 + c2) * 8 + half * 4 + b) * SEQ + tt * 64 + t8);
      unsigned* tp = (unsigned*)(tile + c2 * 66 + t8);
      tp[0] = v[0]; tp[1] = v[1]; tp[2] = v[2]; tp[3] = v[3];
    }
    __syncthreads();
    float fx0[8], fxm[8], fxp[8], fz[8], o[8];
    unpack8(x0, fx0); unpack8(xm, fxm); unpack8(xp, fxp); unpack8(zz, fz);
#pragma unroll
    for (int e = 0; e < 8; ++e) {
      const float x0c = fxm[e] * wx[0][e] + fx0[e] * wx[1][e] + fxp[e] * wx[2][e] + bx[e];
      const float yv = bf2f(tile[(c8 * 8 + e) * 66 + tl]);
      o[e] = x0c * yv * silu(fz[e]);
    }
    u32x4 ov; ov[0] = pack2(o[0], o[1]); ov[1] = pack2(o[2], o[3]); ov[2] = pack2(o[4], o[5]); ov[3] = pack2(o[6], o[7]);
    *(u32x4*)(YBUF + (size_t)(b * SEQ + t) * 2048 + c0) = ov;
  }
}

DI void ssd_prep_phase(int wvs, const bf16_t* __restrict__ PROJ, const float* __restrict__ cw, const float* __restrict__ cb,
                       const float* __restrict__ dt_bias, bf16_t* XBC, float* DT) {
  const int tid = opaque_tid(wvs);
  if (tid < 384) {
    const int c0 = tid * 8;
    float wgt[5][8], bias[8];
#pragma unroll
    for (int j = 0; j < 5; ++j)
#pragma unroll
      for (int e = 0; e < 8; ++e) wgt[j][e] = cw[j * 3072 + c0 + e];
#pragma unroll
    for (int e = 0; e < 8; ++e) bias[e] = cb[c0 + e];
    const u32x4 zero4 = {0u, 0u, 0u, 0u};
    for (int mb = blockIdx.x; mb < MH / 16; mb += gridDim.x) {
      const int m0 = mb * 16, t0 = m0 & (SEQ - 1);
      u32x4 rr[20];
#pragma unroll
      for (int i = 0; i < 20; ++i) {
        const int tt = t0 + i - 2;
        rr[i] = (tt >= 0 && tt < SEQ) ? *(const u32x4*)(PROJ + (size_t)(m0 + i - 2) * 5248 + 2048 + c0) : zero4;
      }
#pragma unroll
      for (int i = 0; i < 16; ++i) {
        float acc[8];
#pragma unroll
        for (int e = 0; e < 8; ++e) acc[e] = bias[e];
#pragma unroll
        for (int j = 0; j < 5; ++j) {
#pragma unroll
          for (int q = 0; q < 4; ++q) {
            acc[2 * q] += lo2f(rr[i + j][q]) * wgt[j][2 * q];
            acc[2 * q + 1] += hi2f(rr[i + j][q]) * wgt[j][2 * q + 1];
          }
        }
        u32x4 o;
#pragma unroll
        for (int q = 0; q < 4; ++q) o[q] = pack2(silu(acc[2 * q]), silu(acc[2 * q + 1]));
        *(u32x4*)(XBC + (size_t)(m0 + i) * 3072 + c0) = o;
      }
    }
  }
  const size_t tot2 = (size_t)MH * 64;
  for (size_t idx = (size_t)blockIdx.x * NT + tid; idx < tot2; idx += (size_t)gridDim.x * NT) {
    const int m = (int)(idx >> 6), j = (int)(idx & 63);
    const float x = bf2f(PROJ[(size_t)m * 5248 + 5120 + j]) + dt_bias[j];
    DT[idx] = x > 20.f ? x : log1pf(expf(x));
  }
}

DI void ssd_scan_phase(int wvs, char* smem, const bf16_t* __restrict__ XBC, const float* __restrict__ DT, const float* __restrict__ a_log,
                       bf16_t* YF, bf16_t* YB) {
  constexpr int SD = 136;
  bf16_t* Cimg = (bf16_t*)smem;
  bf16_t* Bimg = Cimg + 128 * SD;
  bf16_t* Bht = Bimg + 128 * SD;
  bf16_t* Xt = Bht + 128 * SD;
  bf16_t* Simg = Xt + 64 * SD;
  float* csAll = (float*)(Simg + 64 * SD);
  const int tid = opaque_tid(wvs), lane = tid & 63, w = tid >> 6, r = lane & 31, hh = lane >> 5;
  for (int it = blockIdx.x; it < 256; it += gridDim.x) {
    const int dir = it & 1, h = (it >> 1) & 31, b = it >> 6, g = h >> 3;
    const float a = -expf(a_log[dir * 32 + h]);
    bf16_t* Y = dir ? YB : YF;
    f32x16 sacc = zero16();
    const int nb = w & 3, pb = w >> 2;
    const int pb2 = w >> 2, ib2 = (w < 4) ? (w & 3) : 3 - (w & 3);
    const int np = tid & 63, jseg = tid >> 6, pp = tid & 31, j8 = tid >> 5;
#define ROWTOK(ci, i) ((size_t)b * SEQ + (dir ? (SEQ - 1 - ((ci) * 128 + (i))) : ((ci) * 128 + (i))))
    __syncthreads();
    for (int e = tid; e < 64 * SD / 2; e += NT) ((unsigned*)Simg)[e] = 0u;
    {
      const int ci = tid >> 4, sub = tid & 15;
      float v[8], run = 0.f;
#pragma unroll
      for (int e = 0; e < 8; ++e) { run += a * DT[ROWTOK(ci, sub * 8 + e) * 64 + dir * 32 + h]; v[e] = run; }
      float incl = run;
#pragma unroll
      for (int off = 1; off < 16; off <<= 1) { const float tv = __shfl_up(incl, off, 16); if (sub >= off) incl += tv; }
      const float excl = incl - run;
#pragma unroll
      for (int e = 0; e < 8; ++e) csAll[ci * 128 + sub * 8 + e] = excl + v[e];
    }
    u32x4 rc[4]; unsigned rbv[16], rx[8]; float rdt[8];
#define SSD_PREFETCH(cn) do { \
    _Pragma("unroll") for (int itr = 0; itr < 4; ++itr) rc[itr] = *(const u32x4*)(XBC + ROWTOK(cn, (tid >> 4) + 32 * itr) * 3072 + 2560 + g * 128 + (tid & 15) * 8); \
    _Pragma("unroll") for (int jj = 0; jj < 16; ++jj) rbv[jj] = *(const unsigned*)(XBC + ROWTOK(cn, jseg * 16 + jj) * 3072 + 2048 + g * 128 + 2 * np); \
    _Pragma("unroll") for (int e = 0; e < 8; ++e) { rx[e] = *(const unsigned*)(XBC + ROWTOK(cn, j8 * 8 + e) * 3072 + h * 64 + 2 * pp); \
                                                  rdt[e] = DT[ROWTOK(cn, j8 * 8 + e) * 64 + dir * 32 + h]; } } while (0)
    SSD_PREFETCH(0);
    __syncthreads();
    for (int ci = 0; ci < 32; ++ci) {
      const float* cs = csAll + ci * 128;
      const float cs127 = cs[127];
#pragma unroll
      for (int itr = 0; itr < 4; ++itr) *(u32x4*)(Cimg + ((tid >> 4) + 32 * itr) * SD + (tid & 15) * 8) = rc[itr];
#pragma unroll
      for (int jj = 0; jj < 16; ++jj) *(unsigned*)(Bimg + (jseg * 16 + jj) * SD + 2 * np) = rbv[jj];
#pragma unroll
      for (int hf = 0; hf < 2; ++hf) {
        const float4 c0 = *(const float4*)(cs + jseg * 16 + hf * 8), c1 = *(const float4*)(cs + jseg * 16 + hf * 8 + 4);
        float sc[8];
        sc[0] = __expf(cs127 - c0.x); sc[1] = __expf(cs127 - c0.y); sc[2] = __expf(cs127 - c0.z); sc[3] = __expf(cs127 - c0.w);
        sc[4] = __expf(cs127 - c1.x); sc[5] = __expf(cs127 - c1.y); sc[6] = __expf(cs127 - c1.z); sc[7] = __expf(cs127 - c1.w);
        float vlo[8], vhi[8];
#pragma unroll
        for (int e = 0; e < 8; ++e) { vlo[e] = lo2f(rbv[hf * 8 + e]) * sc[e]; vhi[e] = hi2f(rbv[hf * 8 + e]) * sc[e]; }
        *(bf16x8*)(Bht + (2 * np) * SD + jseg * 16 + hf * 8) = pack8f(vlo);
        *(bf16x8*)(Bht + (2 * np + 1) * SD + jseg * 16 + hf * 8) = pack8f(vhi);
      }
      {
        float vlo[8], vhi[8];
#pragma unroll
        for (int e = 0; e < 8; ++e) { vlo[e] = lo2f(rx[e]) * rdt[e]; vhi[e] = hi2f(rx[e]) * rdt[e]; }
        *(bf16x8*)(Xt + (2 * pp) * SD + j8 * 8) = pack8f(vlo);
        *(bf16x8*)(Xt + (2 * pp + 1) * SD + j8 * 8) = pack8f(vhi);
      }
      __syncthreads();
      if (ci + 1 < 32) SSD_PREFETCH(ci + 1);
      {
        f32x16 y1 = zero16(), y2 = zero16();
        const int i = ib2 * 32 + r;
        const float csi = cs[i];
        bf16x8 cf[8];
#pragma unroll
        for (int kk = 0; kk < 8; ++kk) cf[kk] = ldfrag(Cimg + (ib2 * 32 + r) * SD + kk * 16 + 8 * hh);
        for (int jb = 0; jb <= ib2; ++jb) {
          bf16x8 xq[2];
          f32x16 gt = zero16();
#pragma unroll
          for (int hf = 0; hf < 2; ++hf) {
            bf16x8 bq[4];
#pragma unroll
            for (int kk = 0; kk < 4; ++kk) bq[kk] = ldfrag(Bimg + (jb * 32 + r) * SD + (hf * 4 + kk) * 16 + 8 * hh);
            if (hf == 1) {
#pragma unroll
              for (int s2 = 0; s2 < 2; ++s2) xq[s2] = ldfrag_perm(Xt + (pb2 * 32 + r) * SD + jb * 32 + 16 * s2 + 4 * hh);
            }
            __builtin_amdgcn_sched_barrier(0);
#pragma unroll
            for (int kk = 0; kk < 4; ++kk) gt = MFMA(bq[kk], cf[hf * 4 + kk], gt);
            __builtin_amdgcn_sched_barrier(0);
          }
          float wv[16];
#pragma unroll
          for (int g4 = 0; g4 < 4; ++g4) {
            const int j0 = jb * 32 + 8 * g4 + 4 * hh;
            const float4 cj = *(const float4*)(cs + j0);
            wv[4 * g4 + 0] = (j0 + 0 <= i) ? gt[4 * g4 + 0] * __expf(fminf(csi - cj.x, 0.f)) : 0.f;
            wv[4 * g4 + 1] = (j0 + 1 <= i) ? gt[4 * g4 + 1] * __expf(fminf(csi - cj.y, 0.f)) : 0.f;
            wv[4 * g4 + 2] = (j0 + 2 <= i) ? gt[4 * g4 + 2] * __expf(fminf(csi - cj.z, 0.f)) : 0.f;
            wv[4 * g4 + 3] = (j0 + 3 <= i) ? gt[4 * g4 + 3] * __expf(fminf(csi - cj.w, 0.f)) : 0.f;
          }
#pragma unroll
          for (int s2 = 0; s2 < 2; ++s2) y1 = MFMA(xq[s2], pack8f(wv + 8 * s2), y1);
        }
#pragma unroll
        for (int hf = 0; hf < 2; ++hf) {
          bf16x8 sf[4];
#pragma unroll
          for (int kk = 0; kk < 4; ++kk) sf[kk] = ldfrag(Simg + (pb2 * 32 + r) * SD + (hf * 4 + kk) * 16 + 8 * hh);
          __builtin_amdgcn_sched_barrier(0);
#pragma unroll
          for (int kk = 0; kk < 4; ++kk) y2 = MFMA(sf[kk], cf[hf * 4 + kk], y2);
          __builtin_amdgcn_sched_barrier(0);
        }
        const float ecs = __expf(csi);
        bf16_t* yp = Y + ROWTOK(ci, i) * 2048 + h * 64 + pb2 * 32 + 4 * hh;
#pragma unroll
        for (int gq = 0; gq < 4; ++gq) {
          uint2 pk;
          pk.x = pack2(y1[4 * gq] + ecs * y2[4 * gq], y1[4 * gq + 1] + ecs * y2[4 * gq + 1]);
          pk.y = pack2(y1[4 * gq + 2] + ecs * y2[4 * gq + 2], y1[4 * gq + 3] + ecs * y2[4 * gq + 3]);
          *(uint2*)(yp + 8 * gq) = pk;
        }
      }
      {
        const float e127 = __expf(cs127);
#pragma unroll
        for (int q = 0; q < 16; ++q) sacc[q] *= e127;
#pragma unroll
        for (int hf = 0; hf < 2; ++hf) {
          bf16x8 bh[4], xs[4];
#pragma unroll
          for (int kk = 0; kk < 4; ++kk) { bh[kk] = ldfrag(Bht + (nb * 32 + r) * SD + (hf * 4 + kk) * 16 + 8 * hh); xs[kk] = ldfrag(Xt + (pb * 32 + r) * SD + (hf * 4 + kk) * 16 + 8 * hh); }
          __builtin_amdgcn_sched_barrier(0);
#pragma unroll
          for (int kk = 0; kk < 4; ++kk) sacc = MFMA(bh[kk], xs[kk], sacc);
          __builtin_amdgcn_sched_barrier(0);
        }
      }
      __syncthreads();
      {
        const int p = pb * 32 + r;
#pragma unroll
        for (int gq = 0; gq < 4; ++gq) {
          uint2 pk; pk.x = pack2(sacc[4 * gq], sacc[4 * gq + 1]); pk.y = pack2(sacc[4 * gq + 2], sacc[4 * gq + 3]);
          *(uint2*)(Simg + p * SD + nb * 32 + 8 * gq + 4 * hh) = pk;
        }
      }
    }
#undef SSD_PREFETCH
#undef ROWTOK
  }
}

DI void ssd_post_phase(int wvs, const bf16_t* __restrict__ PROJ, const bf16_t* __restrict__ XBC, bf16_t* YF, const bf16_t* __restrict__ YB,
                       const float* __restrict__ d_skip, const float* __restrict__ norm_g, bool dostore = true) {
  const int tid = opaque_tid(wvs);
  const int lane = tid & 63, w = tid >> 6;
  for (int itw = blockIdx.x * 8 + w; itw < MH * 4; itw += gridDim.x * 8) {
    const int m = itw >> 2, grp = itw & 3, col = grp * 512 + lane * 8;
    const u32x4 yf = *(const u32x4*)(YF + (size_t)m * 2048 + col);
    const u32x4 yb = *(const u32x4*)(YB + (size_t)m * 2048 + col);
    const u32x4 xs = *(const u32x4*)(XBC + (size_t)m * 3072 + col);
    const u32x4 zz = *(const u32x4*)(PROJ + (size_t)m * 5248 + col);
    const float dsk = d_skip[col >> 6];
    float v[8];
    float ss = 0.f;
#pragma unroll
    for (int j = 0; j < 4; ++j) {
      v[2 * j] = (lo2f(yf[j]) + lo2f(yb[j]) + lo2f(xs[j]) * dsk) * silu(lo2f(zz[j]));
      v[2 * j + 1] = (hi2f(yf[j]) + hi2f(yb[j]) + hi2f(xs[j]) * dsk) * silu(hi2f(zz[j]));
      ss += v[2 * j] * v[2 * j] + v[2 * j + 1] * v[2 * j + 1];
    }
    const float sc = rsqrtf(wave_sum(ss) * (1.f / 512.f) + 1e-5f);
    const float4 g0 = *(const float4*)(norm_g + col), g1 = *(const float4*)(norm_g + col + 4);
    u32x4 o;
    o[0] = pack2(v[0] * sc * g0.x, v[1] * sc * g0.y); o[1] = pack2(v[2] * sc * g0.z, v[3] * sc * g0.w);
    o[2] = pack2(v[4] * sc * g1.x, v[5] * sc * g1.y); o[3] = pack2(v[6] * sc * g1.z, v[7] * sc * g1.w);
    if (dostore) *(u32x4*)(YF + (size_t)m * 2048 + col) = o;
  }
}

DI void hg_scan_phase(int wvs, char* smem, const bf16_t* __restrict__ PROJ, const float* __restrict__ lbraw, bf16_t* OF, bf16_t* OB) {
  constexpr int SD = 136, SJ = 72;
  bf16_t* Qt = (bf16_t*)smem;
  bf16_t* Qh = Qt + 64 * SD;
  bf16_t* Kt = Qh + 64 * SD;
  bf16_t* Kht = Kt + 64 * SD;
  bf16_t* Vt = Kht + 128 * SJ;
  bf16_t* St = Vt + 64 * SJ;
  float* tot = (float*)(St + 64 * SD);
  float* eG = tot + 1024;
  const int tid = opaque_tid(wvs), lane = tid & 63, w = tid >> 6, r = lane & 31, hh = lane >> 5;
  for (int it = blockIdx.x; it < 256; it += gridDim.x) {
    const int dh = it & 1, dir = (it >> 1) & 1, h = (it >> 2) & 15, b = it >> 6;
    const int kp = lane, seg = w;
    float lbv[2];
#pragma unroll
    for (int u = 0; u < 2; ++u) {
      const int idx = dir * 2048 + h * 128 + 2 * kp + u;
      const float l0 = lbraw[idx], l1 = lbraw[4096 + idx], l2 = lbraw[8192 + idx], l3 = lbraw[12288 + idx];
      const float mx = fmaxf(fmaxf(l0, l1), fmaxf(l2, l3));
      const float e0 = expf(l0 - mx), e1 = expf(l1 - mx), e2 = expf(l2 - mx), e3 = expf(l3 - mx);
      lbv[u] = (e1 + e2) / (e0 + e1 + e2 + e3);
    }
    const float lb0 = lbv[0], lb1 = lbv[1];
    bf16_t* O = dir ? OB : OF;
    f32x16 sacc = zero16();
    const int kb = w & 3, db = w >> 2;
#define ROWTOK(ci, i) ((size_t)b * SEQ + (dir ? (SEQ - 1 - ((ci) * 64 + (i))) : ((ci) * 64 + (i))))
    unsigned rq[8], rf[8]; bf16_t rv[8];
#define HG_PREFETCH(cn) do { \
    _Pragma("unroll") for (int e = 0; e < 8; ++e) { const bf16_t* pr = PROJ + ROWTOK(cn, seg * 8 + e) * 8192 + h * 128; \
      rq[e] = *(const unsigned*)(pr + 2 * kp); rf[e] = *(const unsigned*)(pr + 2048 + dir * 2048 + 2 * kp); rv[e] = pr[6144 + dh * 64 + lane]; } } while (0)
    __syncthreads();
    for (int e = tid; e < 64 * SD / 2; e += NT) ((unsigned*)St)[e] = 0u;
    HG_PREFETCH(0);
    for (int ci = 0; ci < 64; ++ci) {
      float gl0[8], gl1[8], q0[8], q1[8], k0v[8], k1v[8];
      float run0 = 0.f, run1 = 0.f;
#pragma unroll
      for (int e = 0; e < 8; ++e) {
        const float fa = lo2f(rf[e]), fb = hi2f(rf[e]);
        const float sa = __builtin_amdgcn_rcpf(1.f + __builtin_amdgcn_exp2f(-1.4426950408889634f * fa)), sb = __builtin_amdgcn_rcpf(1.f + __builtin_amdgcn_exp2f(-1.4426950408889634f * fb));
        run0 += __builtin_amdgcn_logf(lb0 + (1.f - lb0) * sa); run1 += __builtin_amdgcn_logf(lb1 + (1.f - lb1) * sb);
        gl0[e] = run0; gl1[e] = run1;
        q0[e] = lo2f(rq[e]); q1[e] = hi2f(rq[e]);
        k0v[e] = (1.f - lb0) * (1.f - sa); k1v[e] = (1.f - lb1) * (1.f - sb);
      }
      *(float2*)(tot + seg * 128 + 2 * kp) = make_float2(run0, run1);
      {
        u32x4 vv;
        vv[0] = (unsigned)rv[0] | ((unsigned)rv[1] << 16); vv[1] = (unsigned)rv[2] | ((unsigned)rv[3] << 16);
        vv[2] = (unsigned)rv[4] | ((unsigned)rv[5] << 16); vv[3] = (unsigned)rv[6] | ((unsigned)rv[7] << 16);
        *(u32x4*)(Vt + lane * SJ + seg * 8) = vv;
      }
      __syncthreads();
      {
        float pre0 = 0.f, pre1 = 0.f, gm0 = 0.f, gm1 = 0.f, ga0 = 0.f, ga1 = 0.f;
#pragma unroll
        for (int s2 = 0; s2 < 8; ++s2) {
          const float2 tv = *(const float2*)(tot + s2 * 128 + 2 * kp);
          if (s2 < seg) { pre0 += tv.x; pre1 += tv.y; }
          if (s2 < 4) { gm0 += tv.x; gm1 += tv.y; }
          ga0 += tv.x; ga1 += tv.y;
        }
        const float egm0 = __builtin_amdgcn_exp2f(gm0), egm1 = __builtin_amdgcn_exp2f(gm1), e63m0 = __builtin_amdgcn_exp2f(ga0 - gm0), e63m1 = __builtin_amdgcn_exp2f(ga1 - gm1);
        float kh0[8], kh1[8];
#pragma unroll
        for (int e = 0; e < 8; ++e) {
          const int il = seg * 8 + e;
          const float d0 = pre0 + gl0[e] - gm0, d1 = pre1 + gl1[e] - gm1;
          const float qt0 = q0[e] * __builtin_amdgcn_exp2f(d0), qt1 = q1[e] * __builtin_amdgcn_exp2f(d1);
          const float kt0 = k0v[e] * __builtin_amdgcn_exp2f(-d0), kt1 = k1v[e] * __builtin_amdgcn_exp2f(-d1);
          *(unsigned*)(Qt + il * SD + 2 * kp) = pack2(qt0, qt1);
          *(unsigned*)(Qh + il * SD + 2 * kp) = pack2(qt0 * egm0, qt1 * egm1);
          *(unsigned*)(Kt + il * SD + 2 * kp) = pack2(kt0, kt1);
          kh0[e] = kt0 * e63m0; kh1[e] = kt1 * e63m1;
        }
        *(bf16x8*)(Kht + (2 * kp) * SJ + seg * 8) = pack8f(kh0);
        *(bf16x8*)(Kht + (2 * kp + 1) * SJ + seg * 8) = pack8f(kh1);
        if (seg == 0) *(float2*)(eG + 2 * kp) = make_float2(__builtin_amdgcn_exp2f(ga0), __builtin_amdgcn_exp2f(ga1));
      }
      __syncthreads();
      if (ci + 1 < 64) HG_PREFETCH(ci + 1);
      {
#pragma unroll
        for (int gq = 0; gq < 4; ++gq) {
          const float4 ev = *(const float4*)(eG + kb * 32 + 8 * gq + 4 * hh);
          sacc[4 * gq] *= ev.x; sacc[4 * gq + 1] *= ev.y; sacc[4 * gq + 2] *= ev.z; sacc[4 * gq + 3] *= ev.w;
        }
        bf16x8 kq[4], vq[4];
#pragma unroll
        for (int kk = 0; kk < 4; ++kk) { kq[kk] = ldfrag(Kht + (kb * 32 + r) * SJ + kk * 16 + 8 * hh); vq[kk] = ldfrag(Vt + (db * 32 + r) * SJ + kk * 16 + 8 * hh); }
        __builtin_amdgcn_sched_barrier(0);
#pragma unroll
        for (int kk = 0; kk < 4; ++kk) sacc = MFMA(kq[kk], vq[kk], sacc);
      }
      if (w < 4) {
        const int db2 = w & 1, ib2 = w >> 1;
        const int i = ib2 * 32 + r;
        f32x16 oacc = zero16();
        {
          bf16x8 sq[8], hq[8];
#pragma unroll
          for (int kk = 0; kk < 8; ++kk) { sq[kk] = ldfrag(St + (db2 * 32 + r) * SD + kk * 16 + 8 * hh); hq[kk] = ldfrag(Qh + (ib2 * 32 + r) * SD + kk * 16 + 8 * hh); }
          __builtin_amdgcn_sched_barrier(0);
#pragma unroll
          for (int kk = 0; kk < 8; ++kk) oacc = MFMA(sq[kk], hq[kk], oacc);
          __builtin_amdgcn_sched_barrier(0);
        }
        bf16x8 qf[8];
#pragma unroll
        for (int kk = 0; kk < 8; ++kk) qf[kk] = ldfrag(Qt + (ib2 * 32 + r) * SD + kk * 16 + 8 * hh);
        for (int jb = 0; jb <= ib2; ++jb) {
          bf16x8 kf[8], vperm[2];
#pragma unroll
          for (int kk = 0; kk < 8; ++kk) kf[kk] = ldfrag(Kt + (jb * 32 + r) * SD + kk * 16 + 8 * hh);
#pragma unroll
          for (int s2 = 0; s2 < 2; ++s2) vperm[s2] = ldfrag_perm(Vt + (db2 * 32 + r) * SJ + jb * 32 + 16 * s2 + 4 * hh);
          __builtin_amdgcn_sched_barrier(0);
          f32x16 at = zero16();
#pragma unroll
          for (int kk = 0; kk < 8; ++kk) at = MFMA(kf[kk], qf[kk], at);
          float wv[16];
#pragma unroll
          for (int q = 0; q < 16; ++q) {
            const int j = jb * 32 + 8 * (q >> 2) + 4 * hh + (q & 3);
            wv[q] = (j <= i) ? at[q] : 0.f;
          }
#pragma unroll
          for (int s2 = 0; s2 < 2; ++s2) oacc = MFMA(vperm[s2], pack8f(wv + 8 * s2), oacc);
        }
        bf16_t* op = O + ROWTOK(ci, i) * 2048 + h * 128 + dh * 64 + db2 * 32 + 4 * hh;
#pragma unroll
        for (int gq = 0; gq < 4; ++gq) {
          uint2 pk; pk.x = pack2(oacc[4 * gq], oacc[4 * gq + 1]); pk.y = pack2(oacc[4 * gq + 2], oacc[4 * gq + 3]);
          *(uint2*)(op + 8 * gq) = pk;
        }
      }
      __syncthreads();
      {
        const int d = db * 32 + r;
#pragma unroll
        for (int gq = 0; gq < 4; ++gq) {
          uint2 pk; pk.x = pack2(sacc[4 * gq], sacc[4 * gq + 1]); pk.y = pack2(sacc[4 * gq + 2], sacc[4 * gq + 3]);
          *(uint2*)(St + d * SD + kb * 32 + 8 * gq + 4 * hh) = pk;
        }
      }
    }
#undef HG_PREFETCH
#undef ROWTOK
  }
}

DI void hg_post_phase(int wvs, const bf16_t* __restrict__ ZB, bf16_t* OF, const bf16_t* __restrict__ OB, const float* __restrict__ norm_g, bool dostore = true) {
  const int tid = opaque_tid(wvs);
  const int lane = tid & 63, w = tid >> 6;
  for (int itw = blockIdx.x * 8 + w; itw < MH * 4; itw += gridDim.x * 8) {
    const int m = itw >> 2, grp = itw & 3, col = grp * 512 + lane * 8;
    const u32x4 yf = *(const u32x4*)(OF + (size_t)m * 2048 + col);
    const u32x4 yb = *(const u32x4*)(OB + (size_t)m * 2048 + col);
    const u32x4 zz = *(const u32x4*)(ZB + (size_t)m * 2048 + col);
    float v[8];
    float ss = 0.f;
#pragma unroll
    for (int j = 0; j < 4; ++j) {
      v[2 * j] = lo2f(yf[j]) + lo2f(yb[j]);
      v[2 * j + 1] = hi2f(yf[j]) + hi2f(yb[j]);
      ss += v[2 * j] * v[2 * j] + v[2 * j + 1] * v[2 * j + 1];
    }
    ss += __shfl_xor(ss, 1); ss += __shfl_xor(ss, 2); ss += __shfl_xor(ss, 4); ss += __shfl_xor(ss, 8);
    const float sc = rsqrtf(ss * (1.f / 128.f) + 1e-5f);
    const float4 g0 = *(const float4*)(norm_g + col), g1 = *(const float4*)(norm_g + col + 4);
    u32x4 o;
    o[0] = pack2(v[0] * sc * g0.x * silu(lo2f(zz[0])), v[1] * sc * g0.y * silu(hi2f(zz[0])));
    o[1] = pack2(v[2] * sc * g0.z * silu(lo2f(zz[1])), v[3] * sc * g0.w * silu(hi2f(zz[1])));
    o[2] = pack2(v[4] * sc * g1.x * silu(lo2f(zz[2])), v[5] * sc * g1.y * silu(hi2f(zz[2])));
    o[3] = pack2(v[6] * sc * g1.z * silu(lo2f(zz[3])), v[7] * sc * g1.w * silu(hi2f(zz[3])));
    if (dostore) *(u32x4*)(OF + (size_t)m * 2048 + col) = o;
  }
}

extern "C" __global__ void __launch_bounds__(NT) fwd_megakernel(Params p) {
  extern __shared__ __attribute__((aligned(16))) char smem[];
  cg::grid_group grid = cg::this_grid();
  const int wvs = __builtin_amdgcn_readfirstlane((int)(threadIdx.x >> 6));
  volatile LAS unsigned* bst = (volatile LAS unsigned*)(smem + LDS_BYTES - 16);
  if (xb_is_t0(wvs)) { bst[0] = 0u; bst[1] = 0u; }
  __syncthreads();
  XcdBarrier xb = xcd_barrier_post((unsigned*)(p.ws + OFF_BAR), bst, wvs);
  const float alpha = 1.6817928305074290f;
  bf16_t* HB = (bf16_t*)(p.ws + OFF_HB);
  bf16_t* WTIN = (bf16_t*)(p.ws + OFF_WTIN);
  bf16_t* WTOUT = (bf16_t*)(p.ws + OFF_WTOUT);
  bf16_t* KF = (bf16_t*)(p.ws + OFF_KF);
  bf16_t* KB = (bf16_t*)(p.ws + OFF_KB);
  bf16_t* PROJ = (bf16_t*)(p.ws + OFF_PROJ);
  bf16_t* AUX = (bf16_t*)(p.ws + OFF_AUX);
  float* hbuf = p.out;
  const int one = (p.out != nullptr) ? 1 : 0;
  (void)one;

  for (int rep = 0; rep < REP_MISC; ++rep) cvt_phase(wvs, p.in[0], HB);
  for (int rep = 0; rep < REP_MISC; ++rep) wtrans_phase(wvs, smem, p.in[2], 1024, 8192, 2048, 4096, 4096, WTIN);
  for (int rep = 0; rep < REP_MISC; ++rep) wtrans_phase(wvs, smem, p.in[2], 1024, 8192, 0, 2048, 2048, WTIN + (size_t)4096 * 1024);
  for (int rep = 0; rep < REP_MISC; ++rep) wtrans_phase(wvs, smem, p.in[2], 1024, 8192, 6144, 2048, 2048, WTIN + (size_t)6144 * 1024);
  for (int rep = 0; rep < REP_MISC; ++rep) wtrans_phase(wvs, smem, p.in[14], 2048, 1024, 0, 1024, 1024, WTOUT);
  for (int rep = 0; rep < REP_MISC; ++rep) hy_filter_phase(wvs, smem, p.in[5], p.in[6], p.in[7], p.in[8], p.in[9], p.in[10], p.in[11], p.in[12], p.in[13], KF, KB);
  grid.sync();

  for (int layer = 0; layer < 4; ++layer) {
    if (layer == 0 || layer == 3) {
      const int pbase = layer == 0 ? 2 : 32;
      bf16_t* X1T = (bf16_t*)p.out;
      bf16_t* VT = (bf16_t*)(p.ws + OFF_VT);
      bf16_t* PROJ2 = (bf16_t*)(p.ws + OFF_PROJ2);
      bf16_t* YBUF = (bf16_t*)(p.ws + OFF_YBUF);
      for (int rep = 0; rep < REP_GEMM; ++rep) gemm_phase<2, 4>(wvs, smem, HB, 1024, WTIN, 1024, 128, 16, X1T, 0, nullptr, VT, 0.f, (REP_GEMM == 1) || (rep + one == REP_GEMM));
      for (int rep = 0; rep < REP_SYNC; ++rep) xcd_barrier(xb);
      for (int rep = 0; rep < REP_CONV; ++rep) hy_conv_phase(wvs, smem, X1T, VT, p.in[pbase + 1], p.in[pbase + 2], KF, KB, (REP_CONV == 1) || (rep + one == REP_CONV));
      for (int rep = 0; rep < REP_SYNC; ++rep) xcd_barrier(xb);
      for (int half = 0; half <= 2; ++half) {
        if (half >= 1) { for (int rep = 0; rep < REP_GEMM; ++rep) gemm_phase<1, 3>(wvs, smem, YBUF, 2048, WTOUT, 2048, 64, 4, nullptr, 0, HB + (size_t)(half - 1) * MH * 1024, HB + (size_t)(half - 1) * MH * 1024, alpha, (REP_GEMM == 1) || (rep + one == REP_GEMM)); }
        if (half <= 1) { for (int rep = 0; rep < REP_GEMM; ++rep) gemm_phase<0, 3>(wvs, smem, HB + (size_t)half * MH * 1024, 1024, WTIN + (size_t)4096 * 1024, 1024, 64, 16, PROJ2, 4096, nullptr, nullptr, 0.f, (REP_GEMM == 1) || (rep + one == REP_GEMM)); }
        for (int rep = 0; rep < REP_SYNC; ++rep) xcd_barrier(xb);
        if (half <= 1) {
          for (int rep = 0; rep < REP_HYEW; ++rep) hy_post_phase(wvs, smem, PROJ2, p.in[pbase + 1], p.in[pbase + 2], X1T, YBUF, half);
          for (int rep = 0; rep < REP_SYNC; ++rep) xcd_barrier(xb);
        }
      }
      if (layer == 0) {
        for (int rep = 0; rep < REP_EW2; ++rep) ln_phase(wvs, HB, p.in[15], p.in[16], nullptr, (REP_EW2 == 1) || (rep + one == REP_EW2));
        for (int rep = 0; rep < REP_MISC; ++rep) wtrans_phase(wvs, smem, p.in[17], 1024, 5184, 0, 5184, 5376, WTIN);
        for (int rep = 0; rep < REP_MISC; ++rep) wtrans_phase(wvs, smem, p.in[24], 2048, 1024, 0, 1024, 1024, WTOUT);
        for (int rep = 0; rep < REP_SYNC; ++rep) xcd_barrier(xb);
      } else {
        for (int rep = 0; rep < REP_EW2; ++rep) ln_phase(wvs, HB, p.in[45], p.in[46], hbuf, (REP_EW2 == 1) || (rep + one == REP_EW2));
      }
    } else if (layer == 1) {
      bf16_t* XBC = (bf16_t*)(p.ws + OFF_SSD_XBC);
      bf16_t* YF = (bf16_t*)(p.ws + OFF_SSD_YF);
      bf16_t* YB = (bf16_t*)(p.ws + OFF_SSD_YB);
      float* DT = (float*)(p.ws + OFF_KF);
      for (int half = 0; half <= 2; ++half) {
        if (half >= 1) { for (int rep = 0; rep < REP_GEMM; ++rep) gemm_phase<1, 3>(wvs, smem, YF, 2048, WTOUT, 2048, 64, 4, nullptr, 0, HB + (size_t)(half - 1) * MH * 1024, HB + (size_t)(half - 1) * MH * 1024, alpha, (REP_GEMM == 1) || (rep + one == REP_GEMM)); }
        if (half <= 1) { for (int rep = 0; rep < REP_GEMM; ++rep) gemm_phase<0, 3>(wvs, smem, HB + (size_t)half * MH * 1024, 1024, WTIN, 1024, 64, 21, PROJ, 5248, nullptr, nullptr, 0.f, (REP_GEMM == 1) || (rep + one == REP_GEMM), 5248); }
        for (int rep = 0; rep < REP_SYNC; ++rep) xcd_barrier(xb);
        if (half <= 1) {
          for (int rep = 0; rep < REP_EW2; ++rep) ssd_prep_phase(wvs, PROJ, p.in[18], p.in[19], p.in[20], XBC, DT);
          for (int rep = 0; rep < REP_SYNC; ++rep) xcd_barrier(xb);
          for (int rep = 0; rep < REP_SCAN; ++rep) ssd_scan_phase(wvs, smem, XBC, DT, p.in[21], YF, YB);
          for (int rep = 0; rep < REP_SYNC; ++rep) xcd_barrier(xb);
          for (int rep = 0; rep < REP_EW2; ++rep) ssd_post_phase(wvs, PROJ, XBC, YF, YB, p.in[22], p.in[23], (REP_EW2 == 1) || (rep + one == REP_EW2));
          for (int rep = 0; rep < REP_SYNC; ++rep) xcd_barrier(xb);
        }
      }
      for (int rep = 0; rep < REP_EW2; ++rep) ln_phase(wvs, HB, p.in[25], p.in[26], nullptr, (REP_EW2 == 1) || (rep + one == REP_EW2));
      for (int rep = 0; rep < REP_MISC; ++rep) wtrans_phase(wvs, smem, p.in[27], 1024, 10240, 0, 10240, 10240, WTIN);
      for (int rep = 0; rep < REP_MISC; ++rep) wtrans_phase(wvs, smem, p.in[29], 2048, 1024, 0, 1024, 1024, WTOUT);
      for (int rep = 0; rep < REP_SYNC; ++rep) xcd_barrier(xb);
    } else {
      bf16_t* OF = AUX;
      bf16_t* OB = AUX + (size_t)MH * 2048;
      bf16_t* ZB = (bf16_t*)p.out;
      for (int half = 0; half <= 2; ++half) {
        if (half >= 1) { for (int rep = 0; rep < REP_GEMM; ++rep) gemm_phase<1, 3>(wvs, smem, OF, 2048, WTOUT, 2048, 64, 4, nullptr, 0, HB + (size_t)(half - 1) * MH * 1024, HB + (size_t)(half - 1) * MH * 1024, alpha, (REP_GEMM == 1) || (rep + one == REP_GEMM)); }
        if (half <= 1) { for (int rep = 0; rep < REP_GEMM; ++rep) gemm_phase<0, 3>(wvs, smem, HB + (size_t)half * MH * 1024, 1024, WTIN, 1024, 64, 40, PROJ, 8192, nullptr, ZB, 0.f, (REP_GEMM == 1) || (rep + one == REP_GEMM)); }
        for (int rep = 0; rep < REP_SYNC; ++rep) xcd_barrier(xb);
        if (half <= 1) {
          for (int rep = 0; rep < REP_SCAN; ++rep) hg_scan_phase(wvs, smem, PROJ, p.in[1], OF, OB);
          for (int rep = 0; rep < REP_SYNC; ++rep) xcd_barrier(xb);
          for (int rep = 0; rep < REP_EW2; ++rep) hg_post_phase(wvs, ZB, OF, OB, p.in[28], (REP_EW2 == 1) || (rep + one == REP_EW2));
          for (int rep = 0; rep < REP_SYNC; ++rep) xcd_barrier(xb);
        }
      }
      for (int rep = 0; rep < REP_EW2; ++rep) ln_phase(wvs, HB, p.in[30], p.in[31], nullptr, (REP_EW2 == 1) || (rep + one == REP_EW2));
      for (int rep = 0; rep < REP_MISC; ++rep) wtrans_phase(wvs, smem, p.in[32], 1024, 8192, 2048, 4096, 4096, WTIN);
      for (int rep = 0; rep < REP_MISC; ++rep) wtrans_phase(wvs, smem, p.in[32], 1024, 8192, 0, 2048, 2048, WTIN + (size_t)4096 * 1024);
      for (int rep = 0; rep < REP_MISC; ++rep) wtrans_phase(wvs, smem, p.in[32], 1024, 8192, 6144, 2048, 2048, WTIN + (size_t)6144 * 1024);
      for (int rep = 0; rep < REP_MISC; ++rep) wtrans_phase(wvs, smem, p.in[44], 2048, 1024, 0, 1024, 1024, WTOUT);
      for (int rep = 0; rep < REP_MISC; ++rep) hy_filter_phase(wvs, smem, p.in[35], p.in[36], p.in[37], p.in[38], p.in[39], p.in[40], p.in[41], p.in[42], p.in[43], KF, KB);
      for (int rep = 0; rep < REP_SYNC; ++rep) xcd_barrier(xb);
    }
  }
}

extern "C" void kernel_launch(void* const* d_in, const int* in_sizes, int n_in, void* d_out, int out_size,
                              void* d_ws, size_t ws_size, hipStream_t stream) {
  static int grid_blocks = 0;
  if (!grid_blocks) {
    (void)hipFuncSetAttribute((const void*)fwd_megakernel, hipFuncAttributeMaxDynamicSharedMemorySize, (int)LDS_BYTES);
    int dev = 0, cus = 0, per_cu = 0;
    (void)hipGetDevice(&dev);
    (void)hipDeviceGetAttribute(&cus, hipDeviceAttributeMultiprocessorCount, dev);
    (void)hipOccupancyMaxActiveBlocksPerMultiprocessor(&per_cu, fwd_megakernel, NT, LDS_BYTES);
    if (per_cu < 1) per_cu = 1;
    grid_blocks = cus * per_cu;
    if (grid_blocks > 256) grid_blocks = 256;
  }
  if (grid_blocks != 256) { fprintf(stderr, "unexpected grid %d\n", grid_blocks); return; }
  if (ws_size < WS_NEED || n_in < 47) { fprintf(stderr, "workspace too small: %zu\n", ws_size); return; }
  Params p{};
  for (int i = 0; i < 47; ++i) p.in[i] = (const float*)d_in[i];
  p.out = (float*)d_out;
  p.ws = (char*)d_ws;
  (void)hipMemsetAsync((char*)d_ws + OFF_BAR, 0, XCD_BAR_WORDS * sizeof(unsigned), stream);
  void* args[] = {&p};
  hipError_t e = hipLaunchCooperativeKernel((void*)fwd_megakernel, dim3(grid_blocks), dim3(NT), args, LDS_BYTES, stream);
  if (e != hipSuccess) fprintf(stderr, "cooperative launch failed: %s (grid %d)\n", hipGetErrorString(e), grid_blocks);
}
```

```cpp
#include <hip/hip_runtime.h>
#include <hip/hip_cooperative_groups.h>
#include <cstdio>
namespace cg = cooperative_groups;

typedef unsigned short bf16_t;
typedef short bf16x8 __attribute__((ext_vector_type(8)));
typedef float f32x16 __attribute__((ext_vector_type(16)));
typedef unsigned u32x4 __attribute__((ext_vector_type(4)));
#define DI __device__ __forceinline__
#define MFMA(a, b, c) __builtin_amdgcn_mfma_f32_32x32x16_bf16((a), (b), (c), 0, 0, 0)

#ifndef REP_GEMM
#define REP_GEMM 1
#endif
#ifndef REP_CONV
#define REP_CONV 1
#endif
#ifndef REP_SCAN
#define REP_SCAN 1
#endif
#ifndef REP_SYNC
#define REP_SYNC 1
#endif
#ifndef REP_HYEW
#define REP_HYEW 1
#endif
#ifndef REP_MISC
#define REP_MISC 1
#endif
#ifndef REP_EW2
#define REP_EW2 1
#endif
constexpr int NT = 512;
constexpr size_t LDS_BYTES = 158 * 1024;
constexpr int SEQ = 4096;
constexpr int MTOT = 32768;
constexpr int MH = 16384;
constexpr size_t MiB = 1024 * 1024;
constexpr size_t OFF_HB = 0;
constexpr size_t OFF_WTIN = 64 * MiB;
constexpr size_t OFF_WTOUT = 84 * MiB;
constexpr size_t OFF_KF = 90 * MiB;
constexpr size_t OFF_KB = 106 * MiB;
constexpr size_t OFF_PROJ = 122 * MiB;
constexpr size_t OFF_AUX = 378 * MiB;
constexpr size_t OFF_SSD_XBC = 286 * MiB;
constexpr size_t OFF_SSD_YF = 382 * MiB;
constexpr size_t OFF_SSD_YB = 446 * MiB;
constexpr size_t OFF_VT = 122 * MiB;
constexpr size_t OFF_PROJ2 = 250 * MiB;
constexpr size_t OFF_YBUF = 378 * MiB;
constexpr size_t OFF_BAR = 511 * MiB;
constexpr size_t WS_NEED = 512 * MiB;

struct Params {
  const float* in[47];
  float* out;
  char* ws;
};

DI float bf2f(bf16_t h) { return __uint_as_float(((unsigned)h) << 16); }
typedef __bf16 bf16x2_t __attribute__((ext_vector_type(2)));
typedef float f32x2_t __attribute__((ext_vector_type(2)));
DI unsigned pack2(float a, float b) { f32x2_t v = {a, b}; return __builtin_bit_cast(unsigned, __builtin_convertvector(v, bf16x2_t)); }
DI bf16_t f2bf(float x) { return (bf16_t)(pack2(x, 0.f) & 0xffffu); }
DI float lo2f(unsigned v) { return __uint_as_float(v << 16); }
DI float hi2f(unsigned v) { return __uint_as_float(v & 0xffff0000u); }
DI f32x16 zero16() { f32x16 z; for (int i = 0; i < 16; ++i) z[i] = 0.f; return z; }
DI bf16x8 ldfrag(const bf16_t* p) { return *(const bf16x8*)p; }
DI float silu(float x) { return x * __builtin_amdgcn_rcpf(1.f + __expf(-x)); }
DI int opaque_tid(int wvs) {
  int l; asm volatile("v_mbcnt_lo_u32_b32 %0, -1, 0\n\tv_mbcnt_hi_u32_b32 %0, -1, %0" : "=v"(l));
  return (wvs << 6) | l; }
DI float wave_sum(float v) { for (int o = 32; o >= 1; o >>= 1) v += __shfl_xor(v, o); return v; }


#define XB_TMO      128
#define XB_XCNT(j)  (256  + 64 * (j))
#define XB_XSUB(j)  (1280 + 64 * (j))
#define XB_XGEN(j)  (2304 + 64 * (j))
#define XB_TOP      3328
#define XB_TOPGEN   3392
#define XCD_BAR_WORDS 3456
#define XB_SPIN_CAP (1u << 18)
#define LAS __attribute__((address_space(3)))
__device__ __forceinline__ unsigned xb_ld(unsigned* p)              { return __hip_atomic_load(p, __ATOMIC_RELAXED, __HIP_MEMORY_SCOPE_AGENT); }
__device__ __forceinline__ unsigned xb_add(unsigned* p, unsigned v) { return __hip_atomic_fetch_add(p, v, __ATOMIC_RELAXED, __HIP_MEMORY_SCOPE_AGENT); }
__device__ __forceinline__ unsigned xb_xcc_id() { return (unsigned)__builtin_amdgcn_s_getreg((3 << 11) | 20) & 0xFu; }
#define XB_SPIN(cond, bar) do { unsigned _sp = 0; while (cond) { __builtin_amdgcn_s_sleep(1); \
    if ((++_sp & 255u) == 0u) { if (xb_ld(&(bar)[XB_TMO])) break; if (_sp > XB_SPIN_CAP) { atomicAdd(&(bar)[XB_TMO], 1u); break; } } } } while (0)

struct XcdBarrier {
    unsigned* bar; unsigned x; int wvs;
    volatile LAS unsigned* st;
};

__device__ __forceinline__ bool xb_is_t0(int wvs) { int l; asm volatile("v_mbcnt_lo_u32_b32 %0, -1, 0\n\tv_mbcnt_hi_u32_b32 %0, -1, %0" : "=v"(l)); return wvs == 0 && l == 0; }
__device__ __forceinline__ XcdBarrier xcd_barrier_post(unsigned* bar, volatile LAS unsigned* st, int wvs) {
    XcdBarrier b; b.bar = bar; b.x = xb_xcc_id(); b.st = st; b.wvs = wvs;
    if (xb_is_t0(b.wvs)) (void)xb_add(&bar[XB_XCNT(b.x)], 1u);
    return b;
}
__device__ __forceinline__ void xcd_barrier_complete(unsigned* bar, unsigned x, unsigned& nloc, unsigned& nx) {
    const unsigned G = gridDim.x * gridDim.y * gridDim.z;
    unsigned sum, cnt, mine, sp = 0u;
    for (;;) {
        sum = 0u; cnt = 0u; mine = 0u;
#pragma unroll
        for (unsigned j = 0; j < 16; ++j) { const unsigned c = xb_ld(&bar[XB_XCNT(j)]); sum += c; cnt += (c > 0u) ? 1u : 0u; mine = (j == x) ? c : mine; }
        if (sum == G) break;
        __builtin_amdgcn_s_sleep(1);
        if ((++sp & 255u) == 0u) { if (xb_ld(&bar[XB_TMO])) break; if (sp > XB_SPIN_CAP) { atomicAdd(&bar[XB_TMO], 1u); break; } }
    }
    nloc = mine > 0u ? mine : 1u; nx = cnt > 0u ? cnt : 1u;
}

__device__ __forceinline__ void xcd_barrier(const XcdBarrier& b) {
    asm volatile("s_waitcnt vmcnt(0)" ::: "memory");
    __syncthreads();
    if (xb_is_t0(b.wvs)) {
        unsigned* bar = b.bar;
        __builtin_amdgcn_s_waitcnt(0);
        unsigned nloc = b.st[0], nx = b.st[1];
        if (nloc == 0u) { xcd_barrier_complete(bar, b.x, nloc, nx); b.st[0] = nloc; b.st[1] = nx; }
        const unsigned old = xb_add(&bar[XB_XSUB(b.x)], 1u);
        const unsigned gen = old / nloc;
        if (old + 1u == (gen + 1u) * nloc) {
            __builtin_amdgcn_fence(__ATOMIC_RELEASE, "agent");
            asm volatile("s_waitcnt vmcnt(0)" ::: "memory");
            const unsigned og = xb_add(&bar[XB_TOP], 1u);
            const unsigned tg = og / nx;
            if (og + 1u == (tg + 1u) * nx) xb_add(&bar[XB_TOPGEN], 1u);
            else XB_SPIN(xb_ld(&bar[XB_TOPGEN]) == tg, bar);
            __builtin_amdgcn_fence(__ATOMIC_ACQUIRE, "agent");
            xb_add(&bar[XB_XGEN(b.x)], 1u);
            asm volatile("s_waitcnt vmcnt(0)" ::: "memory");
        } else {
            XB_SPIN(xb_ld(&bar[XB_XGEN(b.x)]) == gen, bar);
            __builtin_amdgcn_fence(__ATOMIC_ACQUIRE, "agent");
            asm volatile("s_waitcnt vmcnt(0)" ::: "memory");
        }
    }
    __syncthreads();
}

template <int MODE, int LMPX>
DI void gemm_phase(int wvs, char* smem, const bf16_t* __restrict__ A, int lda, const bf16_t* __restrict__ Wt, int K, int Mtiles, int Ntiles,
                   bf16_t* C, int ldc, const bf16_t* res, bf16_t* outp, float alpha, bool dostore = true, int nvalid = 1 << 30) {
  constexpr int BUFB = 65536;
  const int tid = opaque_tid(wvs), lane = tid & 63, w = tid >> 6, r = lane & 31, hh = lane >> 5;
  const int wm = w >> 1, wn = w & 1;
  const int xcd = blockIdx.x & 7, slot = blockIdx.x >> 3;
  constexpr int mpx = 1 << LMPX, nslots = 32;
  const int ntx = mpx * Ntiles, nk = K / 64, lnk = (nk == 16) ? 4 : 5;
  if (slot >= ntx) return;
  const int nmine = (ntx - slot + nslots - 1) / nslots;
  const int S = nmine * nk;
  const bool sq = (Ntiles & 7) == 0;
#define G_TILEMAP(q, MT, NT) do { if (sq) { const int grp_ = (q) >> 5, i_ = (q) & 31; \
      MT = xcd * mpx + (grp_ & (mpx / 4 - 1)) * 4 + (i_ & 3); NT = (grp_ >> (LMPX - 2)) * 8 + (i_ >> 2); } \
    else { MT = xcd * mpx + ((q) & (mpx - 1)); NT = (q) >> LMPX; } } while (0)
  const int drr = lane >> 3, dch = (lane & 7) ^ (((w & 1) * 4 + (drr >> 1)) & 7);
  const int drow = w * 8 + drr, dcol = dch * 8;
  const unsigned dA = (unsigned)(drow * lda + dcol), dB = (unsigned)(drow * K + dcol);
#define G_DMA(s0, bufbyte) do { const int s_ = ((s0) < S) ? (s0) : S - 1; \
    const int q_ = slot + (s_ >> lnk) * nslots, kt_ = s_ & (nk - 1); \
    int mt_, nt_; G_TILEMAP(q_, mt_, nt_); \
    const char* Ab_ = (const char*)(A + (size_t)(mt_ * 256) * lda + kt_ * 64);     \
    const char* Bb_ = (const char*)(Wt + (size_t)(nt_ * 256) * K + kt_ * 64); \
    char* L_ = smem + (bufbyte) + w * 1024; \
    _Pragma("unroll") for (int j_ = 0; j_ < 4; ++j_) \
      __builtin_amdgcn_global_load_lds((const unsigned*)(Ab_ + (size_t)(128 * j_) * lda + (2u * dA)), (__attribute__((address_space(3))) unsigned*)(L_ + j_ * 8192), 16, 0, 0); \
    _Pragma("unroll") for (int j_ = 0; j_ < 4; ++j_) \
      __builtin_amdgcn_global_load_lds((const unsigned*)(Bb_ + (size_t)(128 * j_) * K + (2u * dB)), (__attribute__((address_space(3))) unsigned*)(L_ + 32768 + j_ * 8192), 16, 0, 0); } while (0)
  const int fP = r * 128, fsw = (r >> 1) & 7;
  const int fA = wm * 8192 + fP, fB = 32768 + wn * 16384 + fP;
  f32x16 acc[2][4];
#pragma unroll
  for (int i = 0; i < 2; ++i)
#pragma unroll
    for (int j = 0; j < 4; ++j) acc[i][j] = zero16();
  __syncthreads();
  G_DMA(0, 0);
  asm volatile("s_waitcnt vmcnt(0)" ::: "memory");
  asm volatile("s_waitcnt lgkmcnt(0)" ::: "memory"); __builtin_amdgcn_s_barrier(); asm volatile("" ::: "memory");
  int cur = 0;
  for (int s = 0; s < S; ++s) {
    G_DMA(s + 1, cur ^ BUFB);
    {
      const char* Ab = smem + cur + fA;
      const char* Bb = smem + cur + fB;
      __builtin_amdgcn_sched_barrier(0);
#pragma unroll
      for (int kk = 0; kk < 4; ++kk) {
        const int ko = (((kk * 2 + hh) ^ fsw) << 4);
        bf16x8 af[2], wf[4];
        af[0] = *(const bf16x8*)(Ab + ko); af[1] = *(const bf16x8*)(Ab + 4096 + ko);
#pragma unroll
        for (int ni = 0; ni < 4; ++ni) wf[ni] = *(const bf16x8*)(Bb + ni * 4096 + ko);
#pragma unroll
        for (int mi = 0; mi < 2; ++mi)
#pragma unroll
          for (int ni = 0; ni < 4; ++ni) acc[mi][ni] = MFMA(wf[ni], af[mi], acc[mi][ni]);
        if (kk == 1) __builtin_amdgcn_sched_barrier(0);
      }
      __builtin_amdgcn_sched_barrier(0);
    }
    asm volatile("s_waitcnt vmcnt(0)" ::: "memory");
    if ((s & (nk - 1)) == nk - 1) {
      const int q = slot + (s >> lnk) * nslots;
      int mt, nt; G_TILEMAP(q, mt, nt);
      if (dostore) {
#pragma unroll
        for (int mi = 0; mi < 2; ++mi) {
          const size_t m = (size_t)mt * 256 + wm * 64 + mi * 32 + r;
#pragma unroll
          for (int ni = 0; ni < 4; ++ni) {
            if (MODE == 0) {
#pragma unroll
              for (int gp = 0; gp < 2; ++gp) {
                const int g0 = 2 * gp;
                uint2 pa, pb;
                pa.x = pack2(acc[mi][ni][4 * g0], acc[mi][ni][4 * g0 + 1]); pa.y = pack2(acc[mi][ni][4 * g0 + 2], acc[mi][ni][4 * g0 + 3]);
                pb.x = pack2(acc[mi][ni][4 * g0 + 4], acc[mi][ni][4 * g0 + 5]); pb.y = pack2(acc[mi][ni][4 * g0 + 6], acc[mi][ni][4 * g0 + 7]);
                { auto rx = __builtin_amdgcn_permlane32_swap(pa.x, pb.x, false, false); pa.x = rx[0]; pb.x = rx[1]; }
                { auto ry = __builtin_amdgcn_permlane32_swap(pa.y, pb.y, false, false); pa.y = ry[0]; pb.y = ry[1]; }
                const int col = nt * 256 + wn * 128 + ni * 32 + 8 * g0 + 8 * hh;
                const uint4 v4 = make_uint4(pa.x, pa.y, pb.x, pb.y);
                if (outp != nullptr && nt >= 32) *(uint4*)(outp + m * 2048 + (col - 8192)) = v4;
                else if (col < nvalid) *(uint4*)(C + m * ldc + col) = v4;
              }
            } else if (MODE == 1) {
#pragma unroll
              for (int gp = 0; gp < 2; ++gp) {
                const int g0 = 2 * gp;
                const int nb_ = nt * 256 + wn * 128 + ni * 32 + 8 * g0;
                const uint2 ra = *(const uint2*)(res + m * 1024 + nb_ + 4 * hh), rb = *(const uint2*)(res + m * 1024 + nb_ + 8 + 4 * hh);
                uint2 pa, pb;
                pa.x = pack2(alpha * lo2f(ra.x) + acc[mi][ni][4 * g0], alpha * hi2f(ra.x) + acc[mi][ni][4 * g0 + 1]);
                pa.y = pack2(alpha * lo2f(ra.y) + acc[mi][ni][4 * g0 + 2], alpha * hi2f(ra.y) + acc[mi][ni][4 * g0 + 3]);
                pb.x = pack2(alpha * lo2f(rb.x) + acc[mi][ni][4 * g0 + 4], alpha * hi2f(rb.x) + acc[mi][ni][4 * g0 + 5]);
                pb.y = pack2(alpha * lo2f(rb.y) + acc[mi][ni][4 * g0 + 6], alpha * hi2f(rb.y) + acc[mi][ni][4 * g0 + 7]);
                { auto rx = __builtin_amdgcn_permlane32_swap(pa.x, pb.x, false, false); pa.x = rx[0]; pb.x = rx[1]; }
                { auto ry = __builtin_amdgcn_permlane32_swap(pa.y, pb.y, false, false); pa.y = ry[0]; pb.y = ry[1]; }
                *(uint4*)(outp + m * 1024 + nb_ + 8 * hh) = make_uint4(pa.x, pa.y, pb.x, pb.y);
              }
            } else
#pragma unroll
            for (int g = 0; g < 4; ++g) {
              const int n = nt * 256 + wn * 128 + ni * 32 + 8 * g + 4 * hh;
              const float a0 = acc[mi][ni][4 * g], a1 = acc[mi][ni][4 * g + 1], a2 = acc[mi][ni][4 * g + 2], a3 = acc[mi][ni][4 * g + 3];
              if (MODE == 0) {
                uint2 pk; pk.x = pack2(a0, a1); pk.y = pack2(a2, a3);
                if (outp != nullptr && nt >= 32) *(uint2*)(outp + m * 2048 + (n - 8192)) = pk;
                else if (n < nvalid) *(uint2*)(C + m * ldc + n) = pk;
              } else if (MODE == 2) {
                const unsigned p01 = pack2(a0, a1), p23 = pack2(a2, a3);
                const unsigned q01 = (unsigned)__builtin_amdgcn_update_dpp(0, (int)p01, 0xB1, 0xF, 0xF, true);
                const unsigned q23 = (unsigned)__builtin_amdgcn_update_dpp(0, (int)p23, 0xB1, 0xF, 0xF, true);
                const bool odd = (r & 1) != 0;
                const unsigned o01 = odd ? ((q01 >> 16) | (p01 & 0xffff0000u)) : ((p01 & 0xffffu) | (q01 << 16));
                const unsigned o23 = odd ? ((q23 >> 16) | (p23 & 0xffff0000u)) : ((p23 & 0xffffu) | (q23 << 16));
                bf16_t* dst = ((nt < 8) ? C : outp) + ((size_t)((n + (odd ? 1 : 0)) & 2047) * 8 + (m >> 12)) * SEQ + ((m & 4095) & ~(size_t)1);
                *(unsigned*)dst = o01;
                *(unsigned*)(dst + (size_t)16 * SEQ) = o23;
              } else {
                const uint2 rs = *(const uint2*)(res + m * 1024 + n);
                uint2 pk; pk.x = pack2(alpha * lo2f(rs.x) + a0, alpha * hi2f(rs.x) + a1); pk.y = pack2(alpha * lo2f(rs.y) + a2, alpha * hi2f(rs.y) + a3);
                *(uint2*)(outp + m * 1024 + n) = pk;
              }
            }
          }
        }
      }
#pragma unroll
      for (int i = 0; i < 2; ++i)
#pragma unroll
        for (int j = 0; j < 4; ++j) acc[i][j] = zero16();
    }
    asm volatile("s_waitcnt lgkmcnt(0)" ::: "memory"); __builtin_amdgcn_s_barrier(); asm volatile("" ::: "memory");
    cur ^= BUFB;
  }
  asm volatile("s_waitcnt vmcnt(0)" ::: "memory");
  __syncthreads();
#undef G_DMA
#undef G_TILEMAP
}

DI void wtrans_phase(int wvs, char* smem, const float* __restrict__ W, int K, int ldw, int col0, int ncols, int Npad, bf16_t* Wt) {
  float* tile = (float*)smem;
  const int tid = opaque_tid(wvs);
  const int nkt = K / 64, nnt = Npad / 64;
  for (int it = blockIdx.x; it < nkt * nnt; it += gridDim.x) {
    const int kt = it % nkt, nt = it / nkt;
    __syncthreads();
#pragma unroll
    for (int i = 0; i < 8; ++i) {
      const int k = i * 8 + (tid >> 6), n = tid & 63, gn = nt * 64 + n;
      tile[k * 65 + n] = gn < ncols ? W[(size_t)(kt * 64 + k) * ldw + col0 + gn] : 0.f;
    }
    __syncthreads();
    const int n = tid >> 3, k8 = (tid & 7) * 8;
    u32x4 o;
    o[0] = pack2(tile[(k8 + 0) * 65 + n], tile[(k8 + 1) * 65 + n]);
    o[1] = pack2(tile[(k8 + 2) * 65 + n], tile[(k8 + 3) * 65 + n]);
    o[2] = pack2(tile[(k8 + 4) * 65 + n], tile[(k8 + 5) * 65 + n]);
    o[3] = pack2(tile[(k8 + 6) * 65 + n], tile[(k8 + 7) * 65 + n]);
    *(u32x4*)(Wt + (size_t)(nt * 64 + n) * K + kt * 64 + k8) = o;
  }
}

DI void ln_phase(int wvs, bf16_t* HB, const float* __restrict__ g, const float* __restrict__ bta, float* fout, bool dostore = true) {
  const int tid = opaque_tid(wvs);
  const int lane = tid & 63, w = tid >> 6;
  for (int row = blockIdx.x * 8 + w; row < MTOT; row += gridDim.x * 8) {
    bf16_t* p = HB + (size_t)row * 1024;
    float v[16];
    float s = 0.f;
#pragma unroll
    for (int i = 0; i < 2; ++i) {
      const u32x4 raw = *(const u32x4*)(p + i * 512 + lane * 8);
#pragma unroll
      for (int j = 0; j < 4; ++j) { v[i * 8 + 2 * j] = lo2f(raw[j]); v[i * 8 + 2 * j + 1] = hi2f(raw[j]); }
    }
#pragma unroll
    for (int i = 0; i < 16; ++i) s += v[i];
    const float mean = wave_sum(s) * (1.f / 1024.f);
    float q = 0.f;
#pragma unroll
    for (int i = 0; i < 16; ++i) { v[i] -= mean; q += v[i] * v[i]; }
    const float rstd = rsqrtf(wave_sum(q) * (1.f / 1024.f) + 1e-5f);
#pragma unroll
    for (int i = 0; i < 2; ++i) {
      const int c = i * 512 + lane * 8;
      const float4 g0 = *(const float4*)(g + c), g1 = *(const float4*)(g + c + 4), b0 = *(const float4*)(bta + c), b1 = *(const float4*)(bta + c + 4);
      float o[8];
      o[0] = v[i * 8 + 0] * rstd * g0.x + b0.x; o[1] = v[i * 8 + 1] * rstd * g0.y + b0.y; o[2] = v[i * 8 + 2] * rstd * g0.z + b0.z; o[3] = v[i * 8 + 3] * rstd * g0.w + b0.w;
      o[4] = v[i * 8 + 4] * rstd * g1.x + b1.x; o[5] = v[i * 8 + 5] * rstd * g1.y + b1.y; o[6] = v[i * 8 + 6] * rstd * g1.z + b1.z; o[7] = v[i * 8 + 7] * rstd * g1.w + b1.w;
      if (dostore) {
        u32x4 pk; pk[0] = pack2(o[0], o[1]); pk[1] = pack2(o[2], o[3]); pk[2] = pack2(o[4], o[5]); pk[3] = pack2(o[6], o[7]);
        *(u32x4*)(p + c) = pk;
        if (fout) {
          *(float4*)(fout + (size_t)row * 1024 + c) = make_float4(o[0], o[1], o[2], o[3]);
          *(float4*)(fout + (size_t)row * 1024 + c + 4) = make_float4(o[4], o[5], o[6], o[7]);
        }
      }
    }
  }
}

DI void cvt_phase(int wvs, const float* __restrict__ x, bf16_t* HB) {
  const int tid = opaque_tid(wvs);
  const size_t n4 = (size_t)MTOT * 1024 / 4;
  for (size_t i = (size_t)blockIdx.x * NT + tid; i < n4; i += (size_t)gridDim.x * NT) {
    const float4 v = *(const float4*)(x + i * 4);
    uint2 pk; pk.x = pack2(v.x, v.y); pk.y = pack2(v.z, v.w);
    *(uint2*)(HB + i * 4) = pk;
  }
}

DI bf16x8 pack8f(const float* v) {
  u32x4 o; o[0] = pack2(v[0], v[1]); o[1] = pack2(v[2], v[3]); o[2] = pack2(v[4], v[5]); o[3] = pack2(v[6], v[7]);
  return __builtin_bit_cast(bf16x8, o);
}
DI bf16x8 ldfrag_perm(const bf16_t* p) {
  const uint2 lo = *(const uint2*)p, hi = *(const uint2*)(p + 8);
  u32x4 o; o[0] = lo.x; o[1] = lo.y; o[2] = hi.x; o[3] = hi.y;
  return __builtin_bit_cast(bf16x8, o);
}
DI void hy_dense(const float* src, int nin, int sstride, const float* __restrict__ W, const float* __restrict__ bias,
                 const float* __restrict__ freq, float* dst, int tid) {
  const int u = tid & 63, p0 = tid >> 6;
  const float bb = bias[u], fr = freq[u];
  float s[8];
#pragma unroll
  for (int i = 0; i < 8; ++i) s[i] = bb;
#pragma unroll 4
  for (int f = 0; f < nin; ++f) {
    const float wv = W[f * 64 + u];
#pragma unroll
    for (int i = 0; i < 8; ++i) s[i] += src[(p0 + 8 * i) * sstride + f] * wv;
  }
#pragma unroll
  for (int i = 0; i < 8; ++i) dst[(p0 + 8 * i) * 64 + u] = sinf(fr * s[i]);
}

DI void hy_filter_phase(int wvs, char* smem, const float* __restrict__ w1, const float* __restrict__ b1, const float* __restrict__ w2,
                        const float* __restrict__ b2, const float* __restrict__ w3, const float* __restrict__ b3,
                        const float* __restrict__ freq, const float* __restrict__ wout, const float* __restrict__ skip,
                        bf16_t* KF, bf16_t* KB) {
  float* zf = (float*)smem;
  float* hA = zf + 64 * 33;
  float* hB = hA + 64 * 64;
  const int tid = opaque_tid(wvs);
  for (int it = blockIdx.x; it < 512; it += gridDim.x) {
    const int pb = it & 63, cgp = it >> 6;
    __syncthreads();
    for (int e = tid; e < 64 * 33; e += NT) {
      const int pos = e / 33, f = e % 33, t = pb * 64 + pos;
      float val;
      if (f == 0) val = (float)t / 4095.f;
      else {
        const int kb = (f - 1) & 15;
        const float fk = 1e-4f + (float)kb * ((15.f - 1e-4f) / 15.f);
        const float wt = 6.283185307179586f * (float)t / 4096.f;
        val = (f <= 16) ? cosf(fk * wt) : -sinf(fk * wt);
      }
      zf[e] = val;
    }
    __syncthreads();
    hy_dense(zf, 33, 33, w1, b1, freq, hA, tid);
    __syncthreads();
    hy_dense(hA, 64, 64, w2, b2, freq, hB, tid);
    __syncthreads();
    hy_dense(hB, 64, 64, w3, b3, freq, hA, tid);
    __syncthreads();
    {
      const int cc = cgp * 512 + tid, c = cc & 2047;
      float wc[64];
#pragma unroll
      for (int k = 0; k < 64; ++k) wc[k] = wout[(size_t)k * 4096 + cc];
      const float min_d = -15.350567286626973f, max_d = -3.0701134573253945f;
      const float delta = fabsf(min_d + (float)c * ((max_d - min_d) / 2047.f));
      bf16_t* dst = (cc < 2048 ? KF : KB) + (size_t)c * 4096 + pb * 64;
      const float sk = (cc < 2048) ? skip[c] : 0.f;
#pragma unroll 1
      for (int pp = 0; pp < 32; ++pp) {
        float s0 = 0.f, s1 = 0.f;
#pragma unroll
        for (int k4 = 0; k4 < 16; ++k4) {
          const float4 h0 = *(const float4*)(hA + (2 * pp) * 64 + k4 * 4);
          const float4 h1 = *(const float4*)(hA + (2 * pp + 1) * 64 + k4 * 4);
          s0 += h0.x * wc[4 * k4] + h0.y * wc[4 * k4 + 1] + h0.z * wc[4 * k4 + 2] + h0.w * wc[4 * k4 + 3];
          s1 += h1.x * wc[4 * k4] + h1.y * wc[4 * k4 + 1] + h1.z * wc[4 * k4 + 2] + h1.w * wc[4 * k4 + 3];
        }
        const int t = pb * 64 + 2 * pp;
        s0 *= expf(-((float)t / 4095.f) * delta);
        s1 *= expf(-((float)(t + 1) / 4095.f) * delta);
        if (t == 0) s0 += sk;
        *(unsigned*)(dst + 2 * pp) = pack2(s0, s1);
      }
    }
  }
}

DI void unpack8(const u32x4 v, float* f) {
#pragma unroll
  for (int j = 0; j < 4; ++j) { f[2 * j] = lo2f(v[j]); f[2 * j + 1] = hi2f(v[j]); }
}
DI void hy_conv_phase(int wvs, char* smem, bf16_t* X1T, const bf16_t* __restrict__ VT, const float* __restrict__ cw, const float* __restrict__ cb,
                      const bf16_t* __restrict__ KF, const bf16_t* __restrict__ KB, bool dostore = true) {
  bf16_t* Uimg = (bf16_t*)smem;
  bf16_t* R0 = Uimg + 512 * 72;
  bf16_t* R1 = R0 + 8192;
  const int tid = opaque_tid(wvs), lane = tid & 63, w = tid >> 6, n = lane & 31, hh = lane >> 5;
  for (int c = blockIdx.x; c < 2048; c += gridDim.x) {
    const float xa = cw[2048 + c], xb = cw[6144 + 2048 + c], xc = cw[12288 + 2048 + c], xbias = cb[2048 + c];
    const float va = cw[4096 + c], vb = cw[6144 + 4096 + c], vc = cw[12288 + 4096 + c], vbias = cb[4096 + c];
    const bf16_t* xrow = X1T + (size_t)c * 8 * SEQ;
    const bf16_t* vrow = VT + (size_t)c * 8 * SEQ;
    __syncthreads();
#pragma unroll 2
    for (int i = 0; i < 8; ++i) {
      const int e = tid + NT * i, b = e >> 9, t8 = (e & 511) * 8;
      const bf16_t* xp_ = xrow + b * SEQ + t8;
      const bf16_t* vp_ = vrow + b * SEQ + t8;
      const u32x4 xv = *(const u32x4*)xp_, vv = *(const u32x4*)vp_;
      float fx[10], fv[10];
      fx[0] = t8 > 0 ? bf2f(xp_[-1]) : 0.f; fv[0] = t8 > 0 ? bf2f(vp_[-1]) : 0.f;
      fx[9] = t8 + 8 < SEQ ? bf2f(xp_[8]) : 0.f; fv[9] = t8 + 8 < SEQ ? bf2f(vp_[8]) : 0.f;
      unpack8(xv, fx + 1); unpack8(vv, fv + 1);
      float u[8];
#pragma unroll
      for (int j = 0; j < 8; ++j)
        u[j] = (fx[j] * xa + fx[j + 1] * xb + fx[j + 2] * xc + xbias) * (fv[j] * va + fv[j + 1] * vb + fv[j + 2] * vc + vbias);
      *(bf16x8*)(Uimg + ((t8 >> 6) * 8 + b) * 72 + (t8 & 63)) = pack8f(u);
    }
    {
      const int t8 = tid * 8;
      const u32x4 vf = *(const u32x4*)(KF + (size_t)c * SEQ + t8);
      const u32x4 vb2 = *(const u32x4*)(KB + (size_t)c * SEQ + t8);
#pragma unroll
      for (int j = 0; j < 8; ++j) {
        const bf16_t hfv = (bf16_t)((j & 1) ? (vf[j >> 1] >> 16) : (vf[j >> 1] & 0xffffu));
        const bf16_t hbv = (bf16_t)((j & 1) ? (vb2[j >> 1] >> 16) : (vb2[j >> 1] & 0xffffu));
        const int tt = t8 + j;
        const int y = 4095 - tt;
        R0[y] = hfv;
        if (y >= 1) R1[y - 1] = hfv;
        if (tt >= 1) { const int y2 = 4095 + tt; R0[y2] = hbv; R1[y2 - 1] = hbv; }
      }
      if (tid == 0) { R0[8191] = 0; R1[8190] = 0; R1[8191] = 0; }
    }
    __syncthreads();
    const int b = n & 7, t1a = 8 * w + (n >> 3);
    const bf16_t* Rb = (n & 1) ? R0 : (R1 - 1);
    f32x16 acc00 = zero16(), acc01 = zero16(), acc10 = zero16(), acc11 = zero16();
    bf16x8 carry0, carry1;
    {
      const int yb0 = 4095 - 64 * (8 * w - 63) - n + 8 * hh;
      const unsigned* p0 = (const unsigned*)(Rb + yb0 + 32);
      const unsigned* p1 = (const unsigned*)(Rb + yb0 + 48);
      u32x4 a0, a1;
      a0[0] = p0[0]; a0[1] = p0[1]; a0[2] = p0[2]; a0[3] = p0[3];
      a1[0] = p1[0]; a1[1] = p1[1]; a1[2] = p1[2]; a1[3] = p1[3];
      carry0 = __builtin_bit_cast(bf16x8, a0); carry1 = __builtin_bit_cast(bf16x8, a1);
    }
    for (int d1 = 8 * w - 63; d1 <= 8 * w + 7; ++d1) {
      const int s1a = t1a - d1, s1b = s1a + 4;
      const bool va_ = (s1a >= 0) && (s1a < 64), vb_ = (s1b >= 0) && (s1b < 64);
      const bf16_t* urow0 = Uimg + ((va_ ? s1a : 0) * 8 + b) * 72 + 8 * hh;
      const bf16_t* urow1 = Uimg + ((vb_ ? s1b : 0) * 8 + b) * 72 + 8 * hh;
      const int ybase = 4095 - 64 * d1 - n + 8 * hh;
      bf16x8 b0[4], b1[4], af0[4], af1[4];
      __builtin_amdgcn_sched_barrier(0);
#pragma unroll
      for (int ks = 0; ks < 4; ++ks) {
        b0[ks] = ldfrag(urow0 + ks * 16); b1[ks] = ldfrag(urow1 + ks * 16);
        if (ks < 2) {
          const unsigned* p0 = (const unsigned*)(Rb + ybase + 16 * ks);
          const unsigned* p1 = (const unsigned*)(Rb + ybase + 16 * ks - 32);
          u32x4 a0, a1;
          a0[0] = p0[0]; a0[1] = p0[1]; a0[2] = p0[2]; a0[3] = p0[3];
          a1[0] = p1[0]; a1[1] = p1[1]; a1[2] = p1[2]; a1[3] = p1[3];
          af0[ks] = __builtin_bit_cast(bf16x8, a0); af1[ks] = __builtin_bit_cast(bf16x8, a1);
        }
      }
      af0[2] = carry0; af0[3] = carry1; af1[2] = af0[0]; af1[3] = af0[1];
      carry0 = af1[0]; carry1 = af1[1];
      if (!va_) {
#pragma unroll
        for (int ks = 0; ks < 4; ++ks) for (int j = 0; j < 8; ++j) b0[ks][j] = 0;
      }
      if (!vb_) {
#pragma unroll
        for (int ks = 0; ks < 4; ++ks) for (int j = 0; j < 8; ++j) b1[ks][j] = 0;
      }
      __builtin_amdgcn_sched_barrier(0);
#pragma unroll
      for (int ks = 0; ks < 4; ++ks) {
        acc00 = MFMA(af0[ks], b0[ks], acc00); acc01 = MFMA(af1[ks], b0[ks], acc01);
        acc10 = MFMA(af0[ks], b1[ks], acc10); acc11 = MFMA(af1[ks], b1[ks], acc11);
      }
      __builtin_amdgcn_sched_barrier(0);
    }
    if (dostore) {
      bf16_t* dst0 = X1T + ((size_t)c * 8 + b) * SEQ + 64 * t1a + 4 * hh;
      bf16_t* dst1 = dst0 + 64 * 4;
#pragma unroll
      for (int g = 0; g < 4; ++g) {
        uint2 p; p.x = pack2(acc00[4 * g], acc00[4 * g + 1]); p.y = pack2(acc00[4 * g + 2], acc00[4 * g + 3]);
        *(uint2*)(dst0 + 8 * g) = p;
        p.x = pack2(acc01[4 * g], acc01[4 * g + 1]); p.y = pack2(acc01[4 * g + 2], acc01[4 * g + 3]);
        *(uint2*)(dst0 + 32 + 8 * g) = p;
        p.x = pack2(acc10[4 * g], acc10[4 * g + 1]); p.y = pack2(acc10[4 * g + 2], acc10[4 * g + 3]);
        *(uint2*)(dst1 + 8 * g) = p;
        p.x = pack2(acc11[4 * g], acc11[4 * g + 1]); p.y = pack2(acc11[4 * g + 2], acc11[4 * g + 3]);
        *(uint2*)(dst1 + 32 + 8 * g) = p;
      }
    }
  }
}

DI void hy_post_phase(int wvs, char* smem, const bf16_t* __restrict__ PROJ2, const float* __restrict__ cw, const float* __restrict__ cb,
                      const bf16_t* __restrict__ Yt, bf16_t* YBUF, int half) {
  bf16_t* tile = (bf16_t*)smem;
  const int tid = opaque_tid(wvs);
  const int c8 = tid & 7, tl = tid >> 3;
  const int ct = blockIdx.x & 31, c0 = ct * 64 + c8 * 8;
  float wx[3][8], bx[8];
#pragma unroll
  for (int j = 0; j < 3; ++j)
#pragma unroll
    for (int e = 0; e < 8; ++e) wx[j][e] = cw[j * 6144 + c0 + e];
#pragma unroll
  for (int e = 0; e < 8; ++e) bx[e] = cb[c0 + e];
  const u32x4 zero4 = {0u, 0u, 0u, 0u};
  for (int j = blockIdx.x >> 5; j < 256; j += gridDim.x >> 5) {
    const int b = j >> 6, tt = j & 63;
    const int t = tt * 64 + tl;
    const bf16_t* p = PROJ2 + (size_t)(b * SEQ + t) * 4096 + c0;
    const u32x4 x0 = *(const u32x4*)(p), zz = *(const u32x4*)(p + 2048);
    const u32x4 xm = t > 0 ? *(const u32x4*)(p - 4096) : zero4;
    const u32x4 xp = t < SEQ - 1 ? *(const u32x4*)(p + 4096) : zero4;
    __syncthreads();
    {
      const int c2 = tid >> 3, t8 = (tid & 7) * 8;
      const u32x4 v = *(const u32x4*)(Yt + ((size_t)(ct * 64 + c2) * 8 + half * 4 + b) * SEQ + tt * 64 + t8);
      unsigned* tp = (unsigned*)(tile + c2 * 66 + t8);
      tp[0] = v[0]; tp[1] = v[1]; tp[2] = v[2]; tp[3] = v[3];
    }
    __syncthreads();
    float fx0[8], fxm[8], fxp[8], fz[8], o[8];
    unpack8(x0, fx0); unpack8(xm, fxm); unpack8(xp, fxp); unpack8(zz, fz);
#pragma unroll
    for (int e = 0; e < 8; ++e) {
      const float x0c = fxm[e] * wx[0][e] + fx0[e] * wx[1][e] + fxp[e] * wx[2][e] + bx[e];
      const float yv = bf2f(tile[(c8 * 8 + e) * 66 + tl]);
      o[e] = x0c * yv * silu(fz[e]);
    }
    u32x4 ov; ov[0] = pack2(o[0], o[1]); ov[1] = pack2(o[2], o[3]); ov[2] = pack2(o[4], o[5]); ov[3] = pack2(o[6], o[7]);
    *(u32x4*)(YBUF + (size_t)(b * SEQ + t) * 2048 + c0) = ov;
  }
}

DI void ssd_prep_phase(int wvs, const bf16_t* __restrict__ PROJ, const float* __restrict__ cw, const float* __restrict__ cb,
                       const float* __restrict__ dt_bias, bf16_t* XBC, float* DT) {
  const int tid = opaque_tid(wvs);
  if (tid < 384) {
    const int c0 = tid * 8;
    float wgt[5][8], bias[8];
#pragma unroll
    for (int j = 0; j < 5; ++j)
#pragma unroll
      for (int e = 0; e < 8; ++e) wgt[j][e] = cw[j * 3072 + c0 + e];
#pragma unroll
    for (int e = 0; e < 8; ++e) bias[e] = cb[c0 + e];
    const u32x4 zero4 = {0u, 0u, 0u, 0u};
    for (int mb = blockIdx.x; mb < MH / 16; mb += gridDim.x) {
      const int m0 = mb * 16, t0 = m0 & (SEQ - 1);
      u32x4 rr[20];
#pragma unroll
      for (int i = 0; i < 20; ++i) {
        const int tt = t0 + i - 2;
        rr[i] = (tt >= 0 && tt < SEQ) ? *(const u32x4*)(PROJ + (size_t)(m0 + i - 2) * 5248 + 2048 + c0) : zero4;
      }
#pragma unroll
      for (int i = 0; i < 16; ++i) {
        float acc[8];
#pragma unroll
        for (int e = 0; e < 8; ++e) acc[e] = bias[e];
#pragma unroll
        for (int j = 0; j < 5; ++j) {
#pragma unroll
          for (int q = 0; q < 4; ++q) {
            acc[2 * q] += lo2f(rr[i + j][q]) * wgt[j][2 * q];
            acc[2 * q + 1] += hi2f(rr[i + j][q]) * wgt[j][2 * q + 1];
          }
        }
        u32x4 o;
#pragma unroll
        for (int q = 0; q < 4; ++q) o[q] = pack2(silu(acc[2 * q]), silu(acc[2 * q + 1]));
        *(u32x4*)(XBC + (size_t)(m0 + i) * 3072 + c0) = o;
      }
    }
  }
  const size_t tot2 = (size_t)MH * 64;
  for (size_t idx = (size_t)blockIdx.x * NT + tid; idx < tot2; idx += (size_t)gridDim.x * NT) {
    const int m = (int)(idx >> 6), j = (int)(idx & 63);
    const float x = bf2f(PROJ[(size_t)m * 5248 + 5120 + j]) + dt_bias[j];
    DT[idx] = x > 20.f ? x : log1pf(expf(x));
  }
}

DI void ssd_scan_phase(int wvs, char* smem, const bf16_t* __restrict__ XBC, const float* __restrict__ DT, const float* __restrict__ a_log,
                       bf16_t* YF, bf16_t* YB) {
  constexpr int SD = 136;
  bf16_t* Cimg = (bf16_t*)smem;
  bf16_t* Bimg = Cimg + 128 * SD;
  bf16_t* Bht = Bimg + 128 * SD;
  bf16_t* Xt = Bht + 128 * SD;
  bf16_t* Simg = Xt + 64 * SD;
  float* csAll = (float*)(Simg + 64 * SD);
  const int tid = opaque_tid(wvs), lane = tid & 63, w = tid >> 6, r = lane & 31, hh = lane >> 5;
  for (int it = blockIdx.x; it < 256; it += gridDim.x) {
    const int dir = it & 1, h = (it >> 1) & 31, b = it >> 6, g = h >> 3;
    const float a = -expf(a_log[dir * 32 + h]);
    bf16_t* Y = dir ? YB : YF;
    f32x16 sacc = zero16();
    const int nb = w & 3, pb = w >> 2;
    const int pb2 = w >> 2, ib2 = (w < 4) ? (w & 3) : 3 - (w & 3);
    const int np = tid & 63, jseg = tid >> 6, pp = tid & 31, j8 = tid >> 5;
#define ROWTOK(ci, i) ((size_t)b * SEQ + (dir ? (SEQ - 1 - ((ci) * 128 + (i))) : ((ci) * 128 + (i))))
    __syncthreads();
    for (int e = tid; e < 64 * SD / 2; e += NT) ((unsigned*)Simg)[e] = 0u;
    {
      const int ci = tid >> 4, sub = tid & 15;
      float v[8], run = 0.f;
#pragma unroll
      for (int e = 0; e < 8; ++e) { run += a * DT[ROWTOK(ci, sub * 8 + e) * 64 + dir * 32 + h]; v[e] = run; }
      float incl = run;
#pragma unroll
      for (int off = 1; off < 16; off <<= 1) { const float tv = __shfl_up(incl, off, 16); if (sub >= off) incl += tv; }
      const float excl = incl - run;
#pragma unroll
      for (int e = 0; e < 8; ++e) csAll[ci * 128 + sub * 8 + e] = excl + v[e];
    }
    u32x4 rc[4]; unsigned rbv[16], rx[8]; float rdt[8];
#define SSD_PREFETCH(cn) do { \
    _Pragma("unroll") for (int itr = 0; itr < 4; ++itr) rc[itr] = *(const u32x4*)(XBC + ROWTOK(cn, (tid >> 4) + 32 * itr) * 3072 + 2560 + g * 128 + (tid & 15) * 8); \
    _Pragma("unroll") for (int jj = 0; jj < 16; ++jj) rbv[jj] = *(const unsigned*)(XBC + ROWTOK(cn, jseg * 16 + jj) * 3072 + 2048 + g * 128 + 2 * np); \
    _Pragma("unroll") for (int e = 0; e < 8; ++e) { rx[e] = *(const unsigned*)(XBC + ROWTOK(cn, j8 * 8 + e) * 3072 + h * 64 + 2 * pp); \
                                                  rdt[e] = DT[ROWTOK(cn, j8 * 8 + e) * 64 + dir * 32 + h]; } } while (0)
    SSD_PREFETCH(0);
    __syncthreads();
    for (int ci = 0; ci < 32; ++ci) {
      const float* cs = csAll + ci * 128;
      const float cs127 = cs[127];
#pragma unroll
      for (int itr = 0; itr < 4; ++itr) *(u32x4*)(Cimg + ((tid >> 4) + 32 * itr) * SD + (tid & 15) * 8) = rc[itr];
#pragma unroll
      for (int jj = 0; jj < 16; ++jj) *(unsigned*)(Bimg + (jseg * 16 + jj) * SD + 2 * np) = rbv[jj];
#pragma unroll
      for (int hf = 0; hf < 2; ++hf) {
        const float4 c0 = *(const float4*)(cs + jseg * 16 + hf * 8), c1 = *(const float4*)(cs + jseg * 16 + hf * 8 + 4);
        float sc[8];
        sc[0] = __expf(cs127 - c0.x); sc[1] = __expf(cs127 - c0.y); sc[2] = __expf(cs127 - c0.z); sc[3] = __expf(cs127 - c0.w);
        sc[4] = __expf(cs127 - c1.x); sc[5] = __expf(cs127 - c1.y); sc[6] = __expf(cs127 - c1.z); sc[7] = __expf(cs127 - c1.w);
        float vlo[8], vhi[8];
#pragma unroll
        for (int e = 0; e < 8; ++e) { vlo[e] = lo2f(rbv[hf * 8 + e]) * sc[e]; vhi[e] = hi2f(rbv[hf * 8 + e]) * sc[e]; }
        *(bf16x8*)(Bht + (2 * np) * SD + jseg * 16 + hf * 8) = pack8f(vlo);
        *(bf16x8*)(Bht + (2 * np + 1) * SD + jseg * 16 + hf * 8) = pack8f(vhi);
      }
      {
        float vlo[8], vhi[8];
#pragma unroll
        for (int e = 0; e < 8; ++e) { vlo[e] = lo2f(rx[e]) * rdt[e]; vhi[e] = hi2f(rx[e]) * rdt[e]; }
        *(bf16x8*)(Xt + (2 * pp) * SD + j8 * 8) = pack8f(vlo);
        *(bf16x8*)(Xt + (2 * pp + 1) * SD + j8 * 8) = pack8f(vhi);
      }
      __syncthreads();
      if (ci + 1 < 32) SSD_PREFETCH(ci + 1);
      {
        f32x16 y1 = zero16(), y2 = zero16();
        const int i = ib2 * 32 + r;
        const float csi = cs[i];
        bf16x8 cf[8];
#pragma unroll
        for (int kk = 0; kk < 8; ++kk) cf[kk] = ldfrag(Cimg + (ib2 * 32 + r) * SD + kk * 16 + 8 * hh);
        for (int jb = 0; jb <= ib2; ++jb) {
          bf16x8 xq[2];
          f32x16 gt = zero16();
#pragma unroll
          for (int hf = 0; hf < 2; ++hf) {
            bf16x8 bq[4];
#pragma unroll
            for (int kk = 0; kk < 4; ++kk) bq[kk] = ldfrag(Bimg + (jb * 32 + r) * SD + (hf * 4 + kk) * 16 + 8 * hh);
            if (hf == 1) {
#pragma unroll
              for (int s2 = 0; s2 < 2; ++s2) xq[s2] = ldfrag_perm(Xt + (pb2 * 32 + r) * SD + jb * 32 + 16 * s2 + 4 * hh);
            }
            __builtin_amdgcn_sched_barrier(0);
#pragma unroll
            for (int kk = 0; kk < 4; ++kk) gt = MFMA(bq[kk], cf[hf * 4 + kk], gt);
            __builtin_amdgcn_sched_barrier(0);
          }
          float wv[16];
#pragma unroll
          for (int g4 = 0; g4 < 4; ++g4) {
            const int j0 = jb * 32 + 8 * g4 + 4 * hh;
            const float4 cj = *(const float4*)(cs + j0);
            wv[4 * g4 + 0] = (j0 + 0 <= i) ? gt[4 * g4 + 0] * __expf(fminf(csi - cj.x, 0.f)) : 0.f;
            wv[4 * g4 + 1] = (j0 + 1 <= i) ? gt[4 * g4 + 1] * __expf(fminf(csi - cj.y, 0.f)) : 0.f;
            wv[4 * g4 + 2] = (j0 + 2 <= i) ? gt[4 * g4 + 2] * __expf(fminf(csi - cj.z, 0.f)) : 0.f;
            wv[4 * g4 + 3] = (j0 + 3 <= i) ? gt[4 * g4 + 3] * __expf(fminf(csi - cj.w, 0.f)) : 0.f;
          }
#pragma unroll
          for (int s2 = 0; s2 < 2; ++s2) y1 = MFMA(xq[s2], pack8f(wv + 8 * s2), y1);
        }
#pragma unroll
        for (int hf = 0; hf < 2; ++hf) {
          bf16x8 sf[4];
#pragma unroll
          for (int kk = 0; kk < 4; ++kk) sf[kk] = ldfrag(Simg + (pb2 * 32 + r) * SD + (hf * 4 + kk) * 16 + 8 * hh);
          __builtin_amdgcn_sched_barrier(0);
#pragma unroll
          for (int kk = 0; kk < 4; ++kk) y2 = MFMA(sf[kk], cf[hf * 4 + kk], y2);
          __builtin_amdgcn_sched_barrier(0);
        }
        const float ecs = __expf(csi);
        bf16_t* yp = Y + ROWTOK(ci, i) * 2048 + h * 64 + pb2 * 32 + 4 * hh;
#pragma unroll
        for (int gq = 0; gq < 4; ++gq) {
          uint2 pk;
          pk.x = pack2(y1[4 * gq] + ecs * y2[4 * gq], y1[4 * gq + 1] + ecs * y2[4 * gq + 1]);
          pk.y = pack2(y1[4 * gq + 2] + ecs * y2[4 * gq + 2], y1[4 * gq + 3] + ecs * y2[4 * gq + 3]);
          *(uint2*)(yp + 8 * gq) = pk;
        }
      }
      {
        const float e127 = __expf(cs127);
#pragma unroll
        for (int q = 0; q < 16; ++q) sacc[q] *= e127;
#pragma unroll
        for (int hf = 0; hf < 2; ++hf) {
          bf16x8 bh[4], xs[4];
#pragma unroll
          for (int kk = 0; kk < 4; ++kk) { bh[kk] = ldfrag(Bht + (nb * 32 + r) * SD + (hf * 4 + kk) * 16 + 8 * hh); xs[kk] = ldfrag(Xt + (pb * 32 + r) * SD + (hf * 4 + kk) * 16 + 8 * hh); }
          __builtin_amdgcn_sched_barrier(0);
#pragma unroll
          for (int kk = 0; kk < 4; ++kk) sacc = MFMA(bh[kk], xs[kk], sacc);
          __builtin_amdgcn_sched_barrier(0);
        }
      }
      __syncthreads();
      {
        const int p = pb * 32 + r;
#pragma unroll
        for (int gq = 0; gq < 4; ++gq) {
          uint2 pk; pk.x = pack2(sacc[4 * gq], sacc[4 * gq + 1]); pk.y = pack2(sacc[4 * gq + 2], sacc[4 * gq + 3]);
          *(uint2*)(Simg + p * SD + nb * 32 + 8 * gq + 4 * hh) = pk;
        }
      }
    }
#undef SSD_PREFETCH
#undef ROWTOK
  }
}

DI void ssd_post_phase(int wvs, const bf16_t* __restrict__ PROJ, const bf16_t* __restrict__ XBC, bf16_t* YF, const bf16_t* __restrict__ YB,
                       const float* __restrict__ d_skip, const float* __restrict__ norm_g, bool dostore = true) {
  const int tid = opaque_tid(wvs);
  const int lane = tid & 63, w = tid >> 6;
  for (int itw = blockIdx.x * 8 + w; itw < MH * 4; itw += gridDim.x * 8) {
    const int m = itw >> 2, grp = itw & 3, col = grp * 512 + lane * 8;
    const u32x4 yf = *(const u32x4*)(YF + (size_t)m * 2048 + col);
    const u32x4 yb = *(const u32x4*)(YB + (size_t)m * 2048 + col);
    const u32x4 xs = *(const u32x4*)(XBC + (size_t)m * 3072 + col);
    const u32x4 zz = *(const u32x4*)(PROJ + (size_t)m * 5248 + col);
    const float dsk = d_skip[col >> 6];
    float v[8];
    float ss = 0.f;
#pragma unroll
    for (int j = 0; j < 4; ++j) {
      v[2 * j] = (lo2f(yf[j]) + lo2f(yb[j]) + lo2f(xs[j]) * dsk) * silu(lo2f(zz[j]));
      v[2 * j + 1] = (hi2f(yf[j]) + hi2f(yb[j]) + hi2f(xs[j]) * dsk) * silu(hi2f(zz[j]));
      ss += v[2 * j] * v[2 * j] + v[2 * j + 1] * v[2 * j + 1];
    }
    const float sc = rsqrtf(wave_sum(ss) * (1.f / 512.f) + 1e-5f);
    const float4 g0 = *(const float4*)(norm_g + col), g1 = *(const float4*)(norm_g + col + 4);
    u32x4 o;
    o[0] = pack2(v[0] * sc * g0.x, v[1] * sc * g0.y); o[1] = pack2(v[2] * sc * g0.z, v[3] * sc * g0.w);
    o[2] = pack2(v[4] * sc * g1.x, v[5] * sc * g1.y); o[3] = pack2(v[6] * sc * g1.z, v[7] * sc * g1.w);
    if (dostore) *(u32x4*)(YF + (size_t)m * 2048 + col) = o;
  }
}

DI void hg_scan_phase(int wvs, char* smem, const bf16_t* __restrict__ PROJ, const float* __restrict__ lbraw, bf16_t* OF, bf16_t* OB) {
  constexpr int SD = 136, SJ = 72;
  bf16_t* Qt = (bf16_t*)smem;
  bf16_t* Qh = Qt + 64 * SD;
  bf16_t* Kt = Qh + 64 * SD;
  bf16_t* Kht = Kt + 64 * SD;
  bf16_t* Vt = Kht + 128 * SJ;
  bf16_t* St = Vt + 64 * SJ;
  float* tot = (float*)(St + 64 * SD);
  float* eG = tot + 1024;
  const int tid = opaque_tid(wvs), lane = tid & 63, w = tid >> 6, r = lane & 31, hh = lane >> 5;
  for (int it = blockIdx.x; it < 256; it += gridDim.x) {
    const int dh = it & 1, dir = (it >> 1) & 1, h = (it >> 2) & 15, b = it >> 6;
    const int kp = lane, seg = w;
    float lbv[2];
#pragma unroll
    for (int u = 0; u < 2; ++u) {
      const int idx = dir * 2048 + h * 128 + 2 * kp + u;
      const float l0 = lbraw[idx], l1 = lbraw[4096 + idx], l2 = lbraw[8192 + idx], l3 = lbraw[12288 + idx];
      const float mx = fmaxf(fmaxf(l0, l1), fmaxf(l2, l3));
      const float e0 = expf(l0 - mx), e1 = expf(l1 - mx), e2 = expf(l2 - mx), e3 = expf(l3 - mx);
      lbv[u] = (e1 + e2) / (e0 + e1 + e2 + e3);
    }
    const float lb0 = lbv[0], lb1 = lbv[1];
    bf16_t* O = dir ? OB : OF;
    f32x16 sacc = zero16();
    const int kb = w & 3, db = w >> 2;
#define ROWTOK(ci, i) ((size_t)b * SEQ + (dir ? (SEQ - 1 - ((ci) * 64 + (i))) : ((ci) * 64 + (i))))
    unsigned rq[8], rf[8]; bf16_t rv[8];
#define HG_PREFETCH(cn) do { \
    _Pragma("unroll") for (int e = 0; e < 8; ++e) { const bf16_t* pr = PROJ + ROWTOK(cn, seg * 8 + e) * 8192 + h * 128; \
      rq[e] = *(const unsigned*)(pr + 2 * kp); rf[e] = *(const unsigned*)(pr + 2048 + dir * 2048 + 2 * kp); rv[e] = pr[6144 + dh * 64 + lane]; } } while (0)
    __syncthreads();
    for (int e = tid; e < 64 * SD / 2; e += NT) ((unsigned*)St)[e] = 0u;
    HG_PREFETCH(0);
    for (int ci = 0; ci < 64; ++ci) {
      float gl0[8], gl1[8], q0[8], q1[8], k0v[8], k1v[8];
      float run0 = 0.f, run1 = 0.f;
#pragma unroll
      for (int e = 0; e < 8; ++e) {
        const float fa = lo2f(rf[e]), fb = hi2f(rf[e]);
        const float sa = __builtin_amdgcn_rcpf(1.f + __builtin_amdgcn_exp2f(-1.4426950408889634f * fa)), sb = __builtin_amdgcn_rcpf(1.f + __builtin_amdgcn_exp2f(-1.4426950408889634f * fb));
        run0 += __builtin_amdgcn_logf(lb0 + (1.f - lb0) * sa); run1 += __builtin_amdgcn_logf(lb1 + (1.f - lb1) * sb);
        gl0[e] = run0; gl1[e] = run1;
        q0[e] = lo2f(rq[e]); q1[e] = hi2f(rq[e]);
        k0v[e] = (1.f - lb0) * (1.f - sa); k1v[e] = (1.f - lb1) * (1.f - sb);
      }
      *(float2*)(tot + seg * 128 + 2 * kp) = make_float2(run0, run1);
      {
        u32x4 vv;
        vv[0] = (unsigned)rv[0] | ((unsigned)rv[1] << 16); vv[1] = (unsigned)rv[2] | ((unsigned)rv[3] << 16);
        vv[2] = (unsigned)rv[4] | ((unsigned)rv[5] << 16); vv[3] = (unsigned)rv[6] | ((unsigned)rv[7] << 16);
        *(u32x4*)(Vt + lane * SJ + seg * 8) = vv;
      }
      __syncthreads();
      {
        float pre0 = 0.f, pre1 = 0.f, gm0 = 0.f, gm1 = 0.f, ga0 = 0.f, ga1 = 0.f;
#pragma unroll
        for (int s2 = 0; s2 < 8; ++s2) {
          const float2 tv = *(const float2*)(tot + s2 * 128 + 2 * kp);
          if (s2 < seg) { pre0 += tv.x; pre1 += tv.y; }
          if (s2 < 4) { gm0 += tv.x; gm1 += tv.y; }
          ga0 += tv.x; ga1 += tv.y;
        }
        const float egm0 = __builtin_amdgcn_exp2f(gm0), egm1 = __builtin_amdgcn_exp2f(gm1), e63m0 = __builtin_amdgcn_exp2f(ga0 - gm0), e63m1 = __builtin_amdgcn_exp2f(ga1 - gm1);
        float kh0[8], kh1[8];
#pragma unroll
        for (int e = 0; e < 8; ++e) {
          const int il = seg * 8 + e;
          const float d0 = pre0 + gl0[e] - gm0, d1 = pre1 + gl1[e] - gm1;
          const float qt0 = q0[e] * __builtin_amdgcn_exp2f(d0), qt1 = q1[e] * __builtin_amdgcn_exp2f(d1);
          const float kt0 = k0v[e] * __builtin_amdgcn_exp2f(-d0), kt1 = k1v[e] * __builtin_amdgcn_exp2f(-d1);
          *(unsigned*)(Qt + il * SD + 2 * kp) = pack2(qt0, qt1);
          *(unsigned*)(Qh + il * SD + 2 * kp) = pack2(qt0 * egm0, qt1 * egm1);
          *(unsigned*)(Kt + il * SD + 2 * kp) = pack2(kt0, kt1);
          kh0[e] = kt0 * e63m0; kh1[e] = kt1 * e63m1;
        }
        *(bf16x8*)(Kht + (2 * kp) * SJ + seg * 8) = pack8f(kh0);
        *(bf16x8*)(Kht + (2 * kp + 1) * SJ + seg * 8) = pack8f(kh1);
        if (seg == 0) *(float2*)(eG + 2 * kp) = make_float2(__builtin_amdgcn_exp2f(ga0), __builtin_amdgcn_exp2f(ga1));
      }
      __syncthreads();
      if (ci + 1 < 64) HG_PREFETCH(ci + 1);
      {
#pragma unroll
        for (int gq = 0; gq < 4; ++gq) {
          const float4 ev = *(const float4*)(eG + kb * 32 + 8 * gq + 4 * hh);
          sacc[4 * gq] *= ev.x; sacc[4 * gq + 1] *= ev.y; sacc[4 * gq + 2] *= ev.z; sacc[4 * gq + 3] *= ev.w;
        }
        bf16x8 kq[4], vq[4];
#pragma unroll
        for (int kk = 0; kk < 4; ++kk) { kq[kk] = ldfrag(Kht + (kb * 32 + r) * SJ + kk * 16 + 8 * hh); vq[kk] = ldfrag(Vt + (db * 32 + r) * SJ + kk * 16 + 8 * hh); }
        __builtin_amdgcn_sched_barrier(0);
#pragma unroll
        for (int kk = 0; kk < 4; ++kk) sacc = MFMA(kq[kk], vq[kk], sacc);
      }
      if (w < 4) {
        const int db2 = w & 1, ib2 = w >> 1;
        const int i = ib2 * 32 + r;
        f32x16 oacc = zero16();
        {
          bf16x8 sq[8], hq[8];
#pragma unroll
          for (int kk = 0; kk < 8; ++kk) { sq[kk] = ldfrag(St + (db2 * 32 + r) * SD + kk * 16 + 8 * hh); hq[kk] = ldfrag(Qh + (ib2 * 32 + r) * SD + kk * 16 + 8 * hh); }
          __builtin_amdgcn_sched_barrier(0);
#pragma unroll
          for (int kk = 0; kk < 8; ++kk) oacc = MFMA(sq[kk], hq[kk], oacc);
          __builtin_amdgcn_sched_barrier(0);
        }
        bf16x8 qf[8];
#pragma unroll
        for (int kk = 0; kk < 8; ++kk) qf[kk] = ldfrag(Qt + (ib2 * 32 + r) * SD + kk * 16 + 8 * hh);
        for (int jb = 0; jb <= ib2; ++jb) {
          bf16x8 kf[8], vperm[2];
#pragma unroll
          for (int kk = 0; kk < 8; ++kk) kf[kk] = ldfrag(Kt + (jb * 32 + r) * SD + kk * 16 + 8 * hh);
#pragma unroll
          for (int s2 = 0; s2 < 2; ++s2) vperm[s2] = ldfrag_perm(Vt + (db2 * 32 + r) * SJ + jb * 32 + 16 * s2 + 4 * hh);
          __builtin_amdgcn_sched_barrier(0);
          f32x16 at = zero16();
#pragma unroll
          for (int kk = 0; kk < 8; ++kk) at = MFMA(kf[kk], qf[kk], at);
          float wv[16];
#pragma unroll
          for (int q = 0; q < 16; ++q) {
            const int j = jb * 32 + 8 * (q >> 2) + 4 * hh + (q & 3);
            wv[q] = (j <= i) ? at[q] : 0.f;
          }
#pragma unroll
          for (int s2 = 0; s2 < 2; ++s2) oacc = MFMA(vperm[s2], pack8f(wv + 8 * s2), oacc);
        }
        bf16_t* op = O + ROWTOK(ci, i) * 2048 + h * 128 + dh * 64 + db2 * 32 + 4 * hh;
#pragma unroll
        for (int gq = 0; gq < 4; ++gq) {
          uint2 pk; pk.x = pack2(oacc[4 * gq], oacc[4 * gq + 1]); pk.y = pack2(oacc[4 * gq + 2], oacc[4 * gq + 3]);
          *(uint2*)(op + 8 * gq) = pk;
        }
      }
      __syncthreads();
      {
        const int d = db * 32 + r;
#pragma unroll
        for (int gq = 0; gq < 4; ++gq) {
          uint2 pk; pk.x = pack2(sacc[4 * gq], sacc[4 * gq + 1]); pk.y = pack2(sacc[4 * gq + 2], sacc[4 * gq + 3]);
          *(uint2*)(St + d * SD + kb * 32 + 8 * gq + 4 * hh) = pk;
        }
      }
    }
#undef HG_PREFETCH
#undef ROWTOK
  }
}

DI void hg_post_phase(int wvs, const bf16_t* __restrict__ ZB, bf16_t* OF, const bf16_t* __restrict__ OB, const float* __restrict__ norm_g, bool dostore = true) {
  const int tid = opaque_tid(wvs);
  const int lane = tid & 63, w = tid >> 6;
  for (int itw = blockIdx.x * 8 + w; itw < MH * 4; itw += gridDim.x * 8) {
    const int m = itw >> 2, grp = itw & 3, col = grp * 512 + lane * 8;
    const u32x4 yf = *(const u32x4*)(OF + (size_t)m * 2048 + col);
    const u32x4 yb = *(const u32x4*)(OB + (size_t)m * 2048 + col);
    const u32x4 zz = *(const u32x4*)(ZB + (size_t)m * 2048 + col);
    float v[8];
    float ss = 0.f;
#pragma unroll
    for (int j = 0; j < 4; ++j) {
      v[2 * j] = lo2f(yf[j]) + lo2f(yb[j]);
      v[2 * j + 1] = hi2f(yf[j]) + hi2f(yb[j]);
      ss += v[2 * j] * v[2 * j] + v[2 * j + 1] * v[2 * j + 1];
    }
    ss += __shfl_xor(ss, 1); ss += __shfl_xor(ss, 2); ss += __shfl_xor(ss, 4); ss += __shfl_xor(ss, 8);
    const float sc = rsqrtf(ss * (1.f / 128.f) + 1e-5f);
    const float4 g0 = *(const float4*)(norm_g + col), g1 = *(const float4*)(norm_g + col + 4);
    u32x4 o;
    o[0] = pack2(v[0] * sc * g0.x * silu(lo2f(zz[0])), v[1] * sc * g0.y * silu(hi2f(zz[0])));
    o[1] = pack2(v[2] * sc * g0.z * silu(lo2f(zz[1])), v[3] * sc * g0.w * silu(hi2f(zz[1])));
    o[2] = pack2(v[4] * sc * g1.x * silu(lo2f(zz[2])), v[5] * sc * g1.y * silu(hi2f(zz[2])));
    o[3] = pack2(v[6] * sc * g1.z * silu(lo2f(zz[3])), v[7] * sc * g1.w * silu(hi2f(zz[3])));
    if (dostore) *(u32x4*)(OF + (size_t)m * 2048 + col) = o;
  }
}

extern "C" __global__ void __launch_bounds__(NT) fwd_megakernel(Params p) {
  extern __shared__ __attribute__((aligned(16))) char smem[];
  cg::grid_group grid = cg::this_grid();
  const int wvs = __builtin_amdgcn_readfirstlane((int)(threadIdx.x >> 6));
  volatile LAS unsigned* bst = (volatile LAS unsigned*)(smem + LDS_BYTES - 16);
  if (xb_is_t0(wvs)) { bst[0] = 0u; bst[1] = 0u; }
  __syncthreads();
  XcdBarrier xb = xcd_barrier_post((unsigned*)(p.ws + OFF_BAR), bst, wvs);
  const float alpha = 1.6817928305074290f;
  bf16_t* HB = (bf16_t*)(p.ws + OFF_HB);
  bf16_t* WTIN = (bf16_t*)(p.ws + OFF_WTIN);
  bf16_t* WTOUT = (bf16_t*)(p.ws + OFF_WTOUT);
  bf16_t* KF = (bf16_t*)(p.ws + OFF_KF);
  bf16_t* KB = (bf16_t*)(p.ws + OFF_KB);
  bf16_t* PROJ = (bf16_t*)(p.ws + OFF_PROJ);
  bf16_t* AUX = (bf16_t*)(p.ws + OFF_AUX);
  float* hbuf = p.out;
  const int one = (p.out != nullptr) ? 1 : 0;
  (void)one;

  for (int rep = 0; rep < REP_MISC; ++rep) cvt_phase(wvs, p.in[0], HB);
  for (int rep = 0; rep < REP_MISC; ++rep) wtrans_phase(wvs, smem, p.in[2], 1024, 8192, 2048, 4096, 4096, WTIN);
  for (int rep = 0; rep < REP_MISC; ++rep) wtrans_phase(wvs, smem, p.in[2], 1024, 8192, 0, 2048, 2048, WTIN + (size_t)4096 * 1024);
  for (int rep = 0; rep < REP_MISC; ++rep) wtrans_phase(wvs, smem, p.in[2], 1024, 8192, 6144, 2048, 2048, WTIN + (size_t)6144 * 1024);
  for (int rep = 0; rep < REP_MISC; ++rep) wtrans_phase(wvs, smem, p.in[14], 2048, 1024, 0, 1024, 1024, WTOUT);
  for (int rep = 0; rep < REP_MISC; ++rep) hy_filter_phase(wvs, smem, p.in[5], p.in[6], p.in[7], p.in[8], p.in[9], p.in[10], p.in[11], p.in[12], p.in[13], KF, KB);
  grid.sync();

  for (int layer = 0; layer < 4; ++layer) {
    if (layer == 0 || layer == 3) {
      const int pbase = layer == 0 ? 2 : 32;
      bf16_t* X1T = (bf16_t*)p.out;
      bf16_t* VT = (bf16_t*)(p.ws + OFF_VT);
      bf16_t* PROJ2 = (bf16_t*)(p.ws + OFF_PROJ2);
      bf16_t* YBUF = (bf16_t*)(p.ws + OFF_YBUF);
      for (int rep = 0; rep < REP_GEMM; ++rep) gemm_phase<2, 4>(wvs, smem, HB, 1024, WTIN, 1024, 128, 16, X1T, 0, nullptr, VT, 0.f, (REP_GEMM == 1) || (rep + one == REP_GEMM));
      for (int rep = 0; rep < REP_SYNC; ++rep) xcd_barrier(xb);
      for (int rep = 0; rep < REP_CONV; ++rep) hy_conv_phase(wvs, smem, X1T, VT, p.in[pbase + 1], p.in[pbase + 2], KF, KB, (REP_CONV == 1) || (rep + one == REP_CONV));
      for (int rep = 0; rep < REP_SYNC; ++rep) xcd_barrier(xb);
      for (int half = 0; half <= 2; ++half) {
        if (half >= 1) { for (int rep = 0; rep < REP_GEMM; ++rep) gemm_phase<1, 3>(wvs, smem, YBUF, 2048, WTOUT, 2048, 64, 4, nullptr, 0, HB + (size_t)(half - 1) * MH * 1024, HB + (size_t)(half - 1) * MH * 1024, alpha, (REP_GEMM == 1) || (rep + one == REP_GEMM)); }
        if (half <= 1) { for (int rep = 0; rep < REP_GEMM; ++rep) gemm_phase<0, 3>(wvs, smem, HB + (size_t)half * MH * 1024, 1024, WTIN + (size_t)4096 * 1024, 1024, 64, 16, PROJ2, 4096, nullptr, nullptr, 0.f, (REP_GEMM == 1) || (rep + one == REP_GEMM)); }
        for (int rep = 0; rep < REP_SYNC; ++rep) xcd_barrier(xb);
        if (half <= 1) {
          for (int rep = 0; rep < REP_HYEW; ++rep) hy_post_phase(wvs, smem, PROJ2, p.in[pbase + 1], p.in[pbase + 2], X1T, YBUF, half);
          for (int rep = 0; rep < REP_SYNC; ++rep) xcd_barrier(xb);
        }
      }
      if (layer == 0) {
        for (int rep = 0; rep < REP_EW2; ++rep) ln_phase(wvs, HB, p.in[15], p.in[16], nullptr, (REP_EW2 == 1) || (rep + one == REP_EW2));
        for (int rep = 0; rep < REP_MISC; ++rep) wtrans_phase(wvs, smem, p.in[17], 1024, 5184, 0, 5184, 5376, WTIN);
        for (int rep = 0; rep < REP_MISC; ++rep) wtrans_phase(wvs, smem, p.in[24], 2048, 1024, 0, 1024, 1024, WTOUT);
        for (int rep = 0; rep < REP_SYNC; ++rep) xcd_barrier(xb);
      } else {
        for (int rep = 0; rep < REP_EW2; ++rep) ln_phase(wvs, HB, p.in[45], p.in[46], hbuf, (REP_EW2 == 1) || (rep + one == REP_EW2));
      }
    } else if (layer == 1) {
      bf16_t* XBC = (bf16_t*)(p.ws + OFF_SSD_XBC);
      bf16_t* YF = (bf16_t*)(p.ws + OFF_SSD_YF);
      bf16_t* YB = (bf16_t*)(p.ws + OFF_SSD_YB);
      float* DT = (float*)(p.ws + OFF_KF);
      for (int half = 0; half <= 2; ++half) {
        if (half >= 1) { for (int rep = 0; rep < REP_GEMM; ++rep) gemm_phase<1, 3>(wvs, smem, YF, 2048, WTOUT, 2048, 64, 4, nullptr, 0, HB + (size_t)(half - 1) * MH * 1024, HB + (size_t)(half - 1) * MH * 1024, alpha, (REP_GEMM == 1) || (rep + one == REP_GEMM)); }
        if (half <= 1) { for (int rep = 0; rep < REP_GEMM; ++rep) gemm_phase<0, 3>(wvs, smem, HB + (size_t)half * MH * 1024, 1024, WTIN, 1024, 64, 21, PROJ, 5248, nullptr, nullptr, 0.f, (REP_GEMM == 1) || (rep + one == REP_GEMM), 5248); }
        for (int rep = 0; rep < REP_SYNC; ++rep) xcd_barrier(xb);
        if (half <= 1) {
          for (int rep = 0; rep < REP_EW2; ++rep) ssd_prep_phase(wvs, PROJ, p.in[18], p.in[19], p.in[20], XBC, DT);
          for (int rep = 0; rep < REP_SYNC; ++rep) xcd_barrier(xb);
          for (int rep = 0; rep < REP_SCAN; ++rep) ssd_scan_phase(wvs, smem, XBC, DT, p.in[21], YF, YB);
          for (int rep = 0; rep < REP_SYNC; ++rep) xcd_barrier(xb);
          for (int rep = 0; rep < REP_EW2; ++rep) ssd_post_phase(wvs, PROJ, XBC, YF, YB, p.in[22], p.in[23], (REP_EW2 == 1) || (rep + one == REP_EW2));
          for (int rep = 0; rep < REP_SYNC; ++rep) xcd_barrier(xb);
        }
      }
      for (int rep = 0; rep < REP_EW2; ++rep) ln_phase(wvs, HB, p.in[25], p.in[26], nullptr, (REP_EW2 == 1) || (rep + one == REP_EW2));
      for (int rep = 0; rep < REP_MISC; ++rep) wtrans_phase(wvs, smem, p.in[27], 1024, 10240, 0, 10240, 10240, WTIN);
      for (int rep = 0; rep < REP_MISC; ++rep) wtrans_phase(wvs, smem, p.in[29], 2048, 1024, 0, 1024, 1024, WTOUT);
      for (int rep = 0; rep < REP_SYNC; ++rep) xcd_barrier(xb);
    } else {
      bf16_t* OF = AUX;
      bf16_t* OB = AUX + (size_t)MH * 2048;
      bf16_t* ZB = (bf16_t*)p.out;
      for (int half = 0; half <= 2; ++half) {
        if (half >= 1) { for (int rep = 0; rep < REP_GEMM; ++rep) gemm_phase<1, 3>(wvs, smem, OF, 2048, WTOUT, 2048, 64, 4, nullptr, 0, HB + (size_t)(half - 1) * MH * 1024, HB + (size_t)(half - 1) * MH * 1024, alpha, (REP_GEMM == 1) || (rep + one == REP_GEMM)); }
        if (half <= 1) { for (int rep = 0; rep < REP_GEMM; ++rep) gemm_phase<0, 3>(wvs, smem, HB + (size_t)half * MH * 1024, 1024, WTIN, 1024, 64, 40, PROJ, 8192, nullptr, ZB, 0.f, (REP_GEMM == 1) || (rep + one == REP_GEMM)); }
        for (int rep = 0; rep < REP_SYNC; ++rep) xcd_barrier(xb);
        if (half <= 1) {
          for (int rep = 0; rep < REP_SCAN; ++rep) hg_scan_phase(wvs, smem, PROJ, p.in[1], OF, OB);
          for (int rep = 0; rep < REP_SYNC; ++rep) xcd_barrier(xb);
          for (int rep = 0; rep < REP_EW2; ++rep) hg_post_phase(wvs, ZB, OF, OB, p.in[28], (REP_EW2 == 1) || (rep + one == REP_EW2));
          for (int rep = 0; rep < REP_SYNC; ++rep) xcd_barrier(xb);
        }
      }
      for (int rep = 0; rep < REP_EW2; ++rep) ln_phase(wvs, HB, p.in[30], p.in[31], nullptr, (REP_EW2 == 1) || (rep + one == REP_EW2));
      for (int rep = 0; rep < REP_MISC; ++rep) wtrans_phase(wvs, smem, p.in[32], 1024, 8192, 2048, 4096, 4096, WTIN);
      for (int rep = 0; rep < REP_MISC; ++rep) wtrans_phase(wvs, smem, p.in[32], 1024, 8192, 0, 2048, 2048, WTIN + (size_t)4096 * 1024);
      for (int rep = 0; rep < REP_MISC; ++rep) wtrans_phase(wvs, smem, p.in[32], 1024, 8192, 6144, 2048, 2048, WTIN + (size_t)6144 * 1024);
      for (int rep = 0; rep < REP_MISC; ++rep) wtrans_phase(wvs, smem, p.in[44], 2048, 1024, 0, 1024, 1024, WTOUT);
      for (int rep = 0; rep < REP_MISC; ++rep) hy_filter_phase(wvs, smem, p.in[35], p.in[36], p.in[37], p.in[38], p.in[39], p.in[40], p.in[41], p.in[42], p.in[43], KF, KB);
      for (int rep = 0; rep < REP_SYNC; ++rep) xcd_barrier(xb);
    }
  }
}

extern "C" void kernel_launch(void* const* d_in, const int* in_sizes, int n_in, void* d_out, int out_size,
                              void* d_ws, size_t ws_size, hipStream_t stream) {
  static int grid_blocks = 0;
  if (!grid_blocks) {
    (void)hipFuncSetAttribute((const void*)fwd_megakernel, hipFuncAttributeMaxDynamicSharedMemorySize, (int)LDS_BYTES);
    int dev = 0, cus = 0, per_cu = 0;
    (void)hipGetDevice(&dev);
    (void)hipDeviceGetAttribute(&cus, hipDeviceAttributeMultiprocessorCount, dev);
    (void)hipOccupancyMaxActiveBlocksPerMultiprocessor(&per_cu, fwd_megakernel, NT, LDS_BYTES);
    if (per_cu < 1) per_cu = 1;
    grid_blocks = cus * per_cu;
    if (grid_blocks > 256) grid_blocks = 256;
  }
  if (grid_blocks != 256) { fprintf(stderr, "unexpected grid %d\n", grid_blocks); return; }
  if (ws_size < WS_NEED || n_in < 47) { fprintf(stderr, "workspace too small: %zu\n", ws_size); return; }
  Params p{};
  for (int i = 0; i < 47; ++i) p.in[i] = (const float*)d_in[i];
  p.out = (float*)d_out;
  p.ws = (char*)d_ws;
  (void)hipMemsetAsync((char*)d_ws + OFF_BAR, 0, XCD_BAR_WORDS * sizeof(unsigned), stream);
  void* args[] = {&p};
  hipError_t e = hipLaunchCooperativeKernel((void*)fwd_megakernel, dim3(grid_blocks), dim3(NT), args, LDS_BYTES, stream);
  if (e != hipSuccess) fprintf(stderr, "cooperative launch failed: %s (grid %d)\n", hipGetErrorString(e), grid_blocks);
}
```
